# Optimizing an MI355X kernel written in HIP

```python
import math
import jax, jax.numpy as jnp
from jax import lax
import numpy as np

D_MODEL = 1024
BATCH = 4
SEQ = 8192
DEPTH = 2

CHUNK = 64
N_META = 16
Q_BLOCK = 128
DIFF_HEADS = 4
DIFF_HEAD_DIM = 64
DIFF_V_DIM = 2 * DIFF_HEAD_DIM
FOX_HEADS = 8
FOX_HEAD_DIM = 64
DIFF_QK_W = DIFF_HEADS * 2 * DIFF_HEAD_DIM
DIFF_V_W = DIFF_HEADS * DIFF_V_DIM
FOX_W = FOX_HEADS * FOX_HEAD_DIM
EVEN_IN_W = 2 * DIFF_QK_W + DIFF_V_W + 3 * FOX_W + FOX_HEADS
EVEN_MIX_W = DIFF_V_W + FOX_W
RET_HEADS = 4
RET_QK_DIM = D_MODEL // RET_HEADS
RET_V_DIM = 2 * RET_QK_DIM
RET_QK_W = RET_HEADS * RET_QK_DIM
RET_V_W = RET_HEADS * RET_V_DIM
RET_IN_W = 2 * RET_QK_W + 2 * RET_V_W
D_FF = 4 * D_MODEL
N_EVEN = (DEPTH + 1) // 2
N_ODD = DEPTH // 2
DEEPNORM_ALPHA = (2 * DEPTH) ** 0.25
DEEPNORM_BETA = (8 * DEPTH) ** -0.25
LN_EPS = 1e-5
RMS_EPS = 1e-6

kernel_name = "hybrid_diff_fox_retention_deepnorm"

F32 = jnp.float32


def _chunk_id(pos):
    return (pos + CHUNK - N_META) // CHUNK


def _layer_norm(x, g, b):
    xf = x.astype(F32)
    mu = jnp.mean(xf, axis=-1, keepdims=True)
    var = jnp.mean(jnp.square(xf - mu), axis=-1, keepdims=True)
    y = (xf - mu) * lax.rsqrt(var + LN_EPS)
    return (y * g.astype(F32) + b.astype(F32)).astype(x.dtype)


def _rms_norm(x):
    xf = x.astype(F32)
    return xf * lax.rsqrt(jnp.mean(jnp.square(xf), axis=-1, keepdims=True) + RMS_EPS)


def _even_mixer(h, w_in, f_bias, lam_vecs, subln_g, w_out, layer_idx):
    B, L, _ = h.shape
    Lp = -(-L // Q_BLOCK) * Q_BLOCK
    nblk = Lp // Q_BLOCK
    proj = h @ w_in
    offs = [int(o) for o in np.cumsum([DIFF_QK_W, DIFF_QK_W, DIFF_V_W, FOX_W, FOX_W, FOX_W])]
    qa, ka, va, qb, kb, vb, fb = jnp.split(proj, offs, axis=-1)
    pad = ((0, 0), (0, Lp - L), (0, 0))
    qa, ka, va, qb, kb, vb = (jnp.pad(t, pad) for t in (qa, ka, va, qb, kb, vb))
    log_f = jnp.pad(jax.nn.log_sigmoid((fb + f_bias).astype(F32)), pad)
    cum_f = jnp.cumsum(log_f, axis=1).transpose(0, 2, 1)

    qa = qa.reshape(B, nblk, Q_BLOCK, DIFF_HEADS, 2, DIFF_HEAD_DIM).transpose(1, 0, 3, 4, 2, 5)
    ka = ka.reshape(B, Lp, DIFF_HEADS, 2, DIFF_HEAD_DIM).transpose(0, 2, 3, 1, 4)
    va = va.reshape(B, Lp, DIFF_HEADS, DIFF_V_DIM).transpose(0, 2, 1, 3)
    qb = qb.reshape(B, nblk, Q_BLOCK, FOX_HEADS, FOX_HEAD_DIM).transpose(1, 0, 3, 2, 4)
    kb = kb.reshape(B, Lp, FOX_HEADS, FOX_HEAD_DIM).transpose(0, 2, 1, 3)
    vb = vb.reshape(B, Lp, FOX_HEADS, FOX_HEAD_DIM).transpose(0, 2, 1, 3)
    cq = cum_f.reshape(B, FOX_HEADS, nblk, Q_BLOCK).transpose(2, 0, 1, 3)

    lam_init = 0.8 - 0.6 * math.exp(-0.3 * layer_idx)
    lv = lam_vecs.astype(F32)
    lam = jnp.exp(jnp.sum(lv[0] * lv[1])) - jnp.exp(jnp.sum(lv[2] * lv[3])) + lam_init
    slopes = 2.0 ** (-8.0 * jnp.arange(1, DIFF_HEADS + 1, dtype=F32) / DIFF_HEADS)
    scale_a = DIFF_HEAD_DIM ** -0.5
    scale_b = FOX_HEAD_DIM ** -0.5
    k_pos = jnp.arange(Lp)
    k_chunk = _chunk_id(k_pos)
    q_pos_blk = k_pos.reshape(nblk, Q_BLOCK)

    def one_block(args):
        qa_i, qb_i, cq_i, q_pos = args
        dist = jnp.abs(q_pos[:, None] - k_pos[None, :]).astype(F32)
        chunk_vis = k_chunk[None, :] <= _chunk_id(q_pos)[:, None]
        frame_vis = k_pos[None, :] <= q_pos[:, None]
        s_a = jnp.einsum('bhmqd,bhmkd->bhmqk', qa_i, ka).astype(F32) * scale_a \
            - slopes[:, None, None, None] * dist
        p_a = jax.nn.softmax(jnp.where(chunk_vis, s_a, -jnp.inf), axis=-1)
        p_diff = p_a[:, :, 0] - lam * p_a[:, :, 1]
        o_a = jnp.einsum('bhqk,bhkd->bhqd', p_diff.astype(va.dtype), va)
        s_b = jnp.einsum('bhqd,bhkd->bhqk', qb_i, kb).astype(F32) * scale_b \
            + cq_i[..., :, None] - cum_f[:, :, None, :]
        p_b = jax.nn.softmax(jnp.where(frame_vis, s_b, -jnp.inf), axis=-1)
        o_b = jnp.einsum('bhqk,bhkd->bhqd', p_b.astype(vb.dtype), vb)
        return o_a, o_b

    o_a, o_b = lax.map(one_block, (qa, qb, cq, q_pos_blk))
    o_a = o_a.transpose(1, 0, 3, 2, 4).reshape(B, Lp, DIFF_HEADS, DIFF_V_DIM)[:, :L]
    o_a = (_rms_norm(o_a) * subln_g.astype(F32) * (1.0 - lam_init)).astype(h.dtype)
    o_b = o_b.transpose(1, 0, 3, 2, 4).reshape(B, Lp, FOX_W)[:, :L]
    o = jnp.concatenate([o_a.reshape(B, L, DIFF_V_W), o_b.astype(h.dtype)], axis=-1)
    return o @ w_out


def _retention(h, w_in, w_out):
    B, L, _ = h.shape
    proj = h @ w_in
    q, k, v, g = jnp.split(proj, [RET_QK_W, 2 * RET_QK_W, 2 * RET_QK_W + RET_V_W], axis=-1)
    k = k * RET_QK_DIM ** -0.5
    lpad = (-N_META) % CHUNK
    Lr = L + lpad
    nc = Lr // CHUNK

    def to_chunks(t, d):
        t = jnp.pad(t, ((0, 0), (lpad, 0), (0, 0)))
        return t.reshape(B, nc, CHUNK, RET_HEADS, d).transpose(1, 0, 3, 2, 4)

    qc, kc, vc = to_chunks(q, RET_QK_DIM), to_chunks(k, RET_QK_DIM), to_chunks(v, RET_V_DIM)
    log_gamma = jnp.log1p(-(2.0 ** (-5.0 - jnp.arange(RET_HEADS, dtype=F32))))
    idx = jnp.arange(CHUNK, dtype=F32)
    intra = jnp.exp(log_gamma[:, None, None] * jnp.abs(idx[:, None] - idx[None, :]))
    q_dec = jnp.exp(log_gamma[:, None] * (idx + 1.0))[:, :, None]
    k_dec = jnp.exp(log_gamma[:, None] * (CHUNK - 1.0 - idx))[:, :, None]
    c_dec = jnp.exp(log_gamma * CHUNK)[:, None, None]

    def step(state, inp):
        q_i, k_i, v_i = inp
        scores = jnp.einsum('bhid,bhjd->bhij', q_i, k_i) * intra
        o = jnp.einsum('bhij,bhje->bhie', scores, v_i) \
            + jnp.einsum('bhid,bhde->bhie', q_i * q_dec, state)
        state = c_dec * state + jnp.einsum('bhjd,bhje->bhde', k_i * k_dec, v_i)
        return state, o

    s0 = jnp.zeros((B, RET_HEADS, RET_QK_DIM, RET_V_DIM), F32)
    _, o = lax.scan(step, s0, (qc, kc, vc))
    o = o.transpose(1, 0, 3, 2, 4).reshape(B, Lr, RET_HEADS, RET_V_DIM)[:, lpad:]
    o = _rms_norm(o).reshape(B, L, RET_V_W).astype(h.dtype)
    y = jax.nn.silu(g) * o
    return y @ w_out


def _sq_relu_mlp(h, w1, w2):
    return jnp.square(jax.nn.relu(h @ w1)) @ w2


def setup_inputs(seed: int = 0) -> dict:
    key = jax.random.key(seed)
    ks = jax.random.split(key, 13)

    def nrm(k, shape, scale):
        return jax.random.normal(k, shape, F32) * scale

    beta = DEEPNORM_BETA
    x = nrm(ks[0], (BATCH, SEQ, D_MODEL), 1.0)
    meta_tokens = nrm(ks[1], (N_META, D_MODEL), 1.0)
    even_col_scale = jnp.concatenate([
        jnp.ones((2 * DIFF_QK_W,), F32), jnp.full((DIFF_V_W,), beta, F32),
        jnp.ones((2 * FOX_W,), F32), jnp.full((FOX_W,), beta, F32),
        jnp.ones((FOX_HEADS,), F32)])
    even_w_in = nrm(ks[2], (N_EVEN, D_MODEL, EVEN_IN_W), D_MODEL ** -0.5) * even_col_scale
    even_f_bias = jnp.linspace(1.0, 6.0, FOX_HEADS, dtype=F32) + nrm(ks[3], (N_EVEN, FOX_HEADS), 0.1)
    diff_lambda = nrm(ks[4], (N_EVEN, 4, DIFF_HEAD_DIM), 0.1)
    diff_subln_g = 1.0 + nrm(ks[5], (N_EVEN, DIFF_V_DIM), 0.02)
    even_w_out = nrm(ks[6], (N_EVEN, EVEN_MIX_W, D_MODEL), EVEN_MIX_W ** -0.5 * beta)
    ret_col_scale = jnp.concatenate([
        jnp.ones((2 * RET_QK_W,), F32), jnp.full((RET_V_W,), beta, F32), jnp.ones((RET_V_W,), F32)])
    ret_w_in = nrm(ks[7], (N_ODD, D_MODEL, RET_IN_W), D_MODEL ** -0.5) * ret_col_scale
    ret_w_out = nrm(ks[8], (N_ODD, RET_V_W, D_MODEL), RET_V_W ** -0.5 * beta)
    ln_g = 1.0 + nrm(ks[9], (DEPTH, 2, D_MODEL), 0.02)
    ln_b = nrm(ks[10], (DEPTH, 2, D_MODEL), 0.02)
    ffn_w1 = nrm(ks[11], (DEPTH, D_MODEL, D_FF), D_MODEL ** -0.5 * beta)
    ffn_w2 = nrm(ks[12], (DEPTH, D_FF, D_MODEL), D_FF ** -0.5 * beta)
    return {"x": x, "meta_tokens": meta_tokens, "even_w_in": even_w_in, "even_f_bias": even_f_bias,
            "diff_lambda": diff_lambda, "diff_subln_g": diff_subln_g, "even_w_out": even_w_out,
            "ret_w_in": ret_w_in, "ret_w_out": ret_w_out, "ln_g": ln_g, "ln_b": ln_b,
            "ffn_w1": ffn_w1, "ffn_w2": ffn_w2}


def reference(x, meta_tokens, even_w_in, even_f_bias, diff_lambda, diff_subln_g, even_w_out,
              ret_w_in, ret_w_out, ln_g, ln_b, ffn_w1, ffn_w2):
    B = x.shape[0]
    meta = jnp.broadcast_to(meta_tokens[None].astype(x.dtype), (B, N_META, D_MODEL))
    h = jnp.concatenate([meta, x], axis=1)
    for layer in range(DEPTH):
        i = layer // 2
        if layer % 2 == 0:
            mix = _even_mixer(h, even_w_in[i], even_f_bias[i], diff_lambda[i], diff_subln_g[i],
                              even_w_out[i], layer)
        else:
            mix = _retention(h, ret_w_in[i], ret_w_out[i])
        h = _layer_norm(DEEPNORM_ALPHA * h + mix, ln_g[layer, 0], ln_b[layer, 0])
        h = _layer_norm(DEEPNORM_ALPHA * h + _sq_relu_mlp(h, ffn_w1[layer], ffn_w2[layer]),
                        ln_g[layer, 1], ln_b[layer, 1])
    return h[:, N_META:, :]
```

```cpp
#include <hip/hip_runtime.h>
#include <hip/hip_cooperative_groups.h>
#include <cstdio>
#include <cstdint>
namespace cg = cooperative_groups;

#ifndef MEGA
#define MEGA 0
#endif

#define DI __device__ __forceinline__
typedef unsigned short bf16_t;
typedef __attribute__((ext_vector_type(8))) short bf16x8;
typedef __attribute__((ext_vector_type(16))) float f32x16;
typedef __attribute__((ext_vector_type(4))) float f32x4;
typedef __attribute__((ext_vector_type(2))) float f32x2;
typedef __attribute__((ext_vector_type(2))) __bf16 bf16x2v;
typedef __attribute__((ext_vector_type(4))) unsigned u32x4;
typedef __attribute__((ext_vector_type(2))) unsigned u32x2;

constexpr int BATCH = 4, LT = 8208, MT = BATCH * LT  , LP = 8320, LR = 8256, DM = 1024;
constexpr int NTM = (MT + 127) / 128;
constexpr int NCH = 129;
constexpr float LOG2E = 1.4426950408889634f;
constexpr float ALPHA = 1.4142135623730951f;

constexpr size_t SZ_W0IN = 3072ull * 1024 * 2, SZ_W0OUT = 1024ull * 1024 * 2, SZ_W1IN = 6144ull * 1024 * 2, SZ_W1OUT = 1024ull * 2048 * 2, SZ_F = 4096ull * 1024 * 2;
constexpr size_t OFF_W0IN = 0;
constexpr size_t OFF_W0OUT = OFF_W0IN + SZ_W0IN;
constexpr size_t OFF_W1IN = OFF_W0OUT + SZ_W0OUT;
constexpr size_t OFF_W1OUT = OFF_W1IN + SZ_W1IN;
constexpr size_t OFF_F1 = OFF_W1OUT + SZ_W1OUT;
constexpr size_t OFF_F2 = OFF_F1 + 2 * SZ_F;
constexpr size_t OFF_H = OFF_F2 + 2 * SZ_F;
constexpr size_t OFF_HB = OFF_H + (size_t)MT * 1024 * 4;
constexpr size_t OFF_LOGF = OFF_HB + (size_t)MT * 1024 * 2;
constexpr size_t OFF_CUMF = OFF_LOGF + (size_t)BATCH * 8 * LP * 4;
constexpr size_t OFF_MISC = OFF_CUMF + (size_t)BATCH * 8 * LP * 4;
constexpr size_t OFF_R = OFF_MISC + 4096;
constexpr size_t OFF_PQK = OFF_R;
constexpr size_t OFF_VTA = OFF_PQK + (size_t)MT * 2048 * 2;
constexpr size_t OFF_VTB = OFF_VTA + (size_t)BATCH * 512 * LP * 2;
constexpr size_t OFF_U = OFF_R;
constexpr size_t OFF_KHAT = OFF_R;
constexpr size_t OFF_KHATT = OFF_KHAT + (size_t)MT * 1024 * 2;
constexpr size_t OFF_VT1 = OFF_KHATT + (size_t)BATCH * 1024 * LR * 2;
constexpr size_t OFF_YB = OFF_KHAT;
constexpr size_t WS_END = OFF_VT1 + (size_t)BATCH * 2048 * LR * 2;
static_assert(OFF_U + (size_t)MT * 4096 * 2 <= WS_END + 4000000, "ws");
static_assert(WS_END <= 536870912ull, "ws too big");
static_assert((size_t)MT * 2048 * 2 <= (OFF_VT1 - OFF_KHAT), "yb alias");
constexpr size_t OFFO_QHAT = 0;
constexpr size_t OFFO_SBUF = OFFO_QHAT + (size_t)MT * 1024 * 2;
constexpr size_t OFFO_PART = OFFO_SBUF + (size_t)NCH * 16 * 4096 * 2;
static_assert(OFFO_PART + (size_t)MT * 64 * 4 <= 134217728ull, "out scratch");

struct Params {
    const float *x, *meta, *ew_in, *ef_bias, *dlam, *subln, *ew_out, *rw_in, *rw_out, *ln_g, *ln_b, *f_w1, *f_w2;
    float* out;
    unsigned char* ws;
};

DI unsigned cvt_pk(float lo, float hi) { f32x2 v = {lo, hi}; bf16x2v b = __builtin_convertvector(v, bf16x2v); return __builtin_bit_cast(unsigned, b); }
DI bf16_t f2bf(float x) { return (bf16_t)(cvt_pk(x, 0.f) & 0xffffu); }
DI f32x16 mfma32(bf16x8 a, bf16x8 b, f32x16 c) { return __builtin_amdgcn_mfma_f32_32x32x16_bf16(a, b, c, 0, 0, 0); }
DI int crow(int reg, int h) { return (reg & 3) + 8 * (reg >> 2) + 4 * h; }
DI int perm23(int r) { return (r & 0x13) | ((r & 4) << 1) | ((r & 8) >> 1); }
template <int S> DI bf16x8 pack8(const f32x16& x) {
    u32x4 p;
    p[0] = cvt_pk(x[8 * S + 0], x[8 * S + 1]); p[1] = cvt_pk(x[8 * S + 2], x[8 * S + 3]);
    p[2] = cvt_pk(x[8 * S + 4], x[8 * S + 5]); p[3] = cvt_pk(x[8 * S + 6], x[8 * S + 7]);
    return __builtin_bit_cast(bf16x8, p);
}
DI f32x16 zero16() { f32x16 z; for (int i = 0; i < 16; ++i) z[i] = 0.f; return z; }
DI float ex2(float x) { return __builtin_amdgcn_exp2f(x); }

constexpr int SMEM_ELEMS = 2 * 2 * 128 * 72;

DI void transpose_tile(const float* __restrict__ src, int ld, bf16_t* __restrict__ dst, int K, int k0, int n0, float* tile) {
    const int tid = threadIdx.x;
#pragma unroll 4
    for (int i = 0; i < 16; ++i) { const int k = (tid >> 6) + 4 * i, n = tid & 63; tile[k * 65 + n] = src[(size_t)(k0 + k) * ld + n0 + n]; }
    __syncthreads();
#pragma unroll 4
    for (int i = 0; i < 16; ++i) { const int n = (tid >> 6) + 4 * i, k = tid & 63; dst[(size_t)(n0 + n) * K + k0 + k] = f2bf(tile[k * 65 + n]); }
    __syncthreads();
}

DI void ph_prologue(const Params& p, bf16_t* smem) {
    float* tile = (float*)smem;
    const int tid = threadIdx.x;
    for (int it = blockIdx.x; it < 7168; it += gridDim.x) {
        const float* src; int ld, K, N; bf16_t* dst; int t = it;
        if (t < 768) { src = p.ew_in; ld = 3080; K = 1024; N = 3072; dst = (bf16_t*)(p.ws + OFF_W0IN); }
        else if ((t -= 768) < 256) { src = p.ew_out; ld = 1024; K = 1024; N = 1024; dst = (bf16_t*)(p.ws + OFF_W0OUT); }
        else if ((t -= 256) < 1536) { src = p.rw_in; ld = 6144; K = 1024; N = 6144; dst = (bf16_t*)(p.ws + OFF_W1IN); }
        else if ((t -= 1536) < 512) { src = p.rw_out; ld = 1024; K = 2048; N = 1024; dst = (bf16_t*)(p.ws + OFF_W1OUT); }
        else if ((t -= 512) < 2048) { const int l = t >> 10; t &= 1023; src = p.f_w1 + (size_t)l * 1024 * 4096; ld = 4096; K = 1024; N = 4096; dst = (bf16_t*)(p.ws + OFF_F1 + l * SZ_F); }
        else { t -= 2048; const int l = t >> 10; t &= 1023; src = p.f_w2 + (size_t)l * 4096 * 1024; ld = 1024; K = 4096; N = 1024; dst = (bf16_t*)(p.ws + OFF_F2 + l * SZ_F); }
        const int ntn = N >> 6;
        transpose_tile(src, ld, dst, K, (t / ntn) * 64, (t % ntn) * 64, tile);
    }
    float* H = (float*)(p.ws + OFF_H); bf16_t* HB = (bf16_t*)(p.ws + OFF_HB);
    for (size_t idx = (size_t)blockIdx.x * 256 + tid; idx < (size_t)MT * 256; idx += (size_t)gridDim.x * 256) {
        const int m = (int)(idx >> 8), c4 = (int)(idx & 255);
        const int b = m / LT, pos = m - b * LT;
        const float* s = pos < 16 ? p.meta + (size_t)pos * 1024 : p.x + ((size_t)b * 8192 + (pos - 16)) * 1024;
        const f32x4 v = *(const f32x4*)(s + c4 * 4);
        *(f32x4*)(H + (size_t)m * 1024 + c4 * 4) = v;
        u32x2 w; w[0] = cvt_pk(v[0], v[1]); w[1] = cvt_pk(v[2], v[3]);
        *(u32x2*)(HB + (size_t)m * 1024 + c4 * 4) = w;
    }
    bf16_t* VT = (bf16_t*)(p.ws + OFF_VTA);
    for (int idx = blockIdx.x * 256 + tid; idx < 4096 * 14; idx += gridDim.x * 256) {
        const int row = idx / 14, c = idx % 14;
        *(u32x4*)(VT + (size_t)row * LP + LT + c * 8) = (u32x4){0u, 0u, 0u, 0u};
    }
    if (blockIdx.x == 0 && tid < 64) {
        float a = p.dlam[tid] * p.dlam[64 + tid], b = p.dlam[128 + tid] * p.dlam[192 + tid];
        for (int o = 32; o > 0; o >>= 1) { a += __shfl_xor(a, o); b += __shfl_xor(b, o); }
        if (tid == 0) ((float*)(p.ws + OFF_MISC))[0] = __expf(a) - __expf(b) + 0.2f;
    }
}

enum { EPI_E1 = 0, EPI_RESID = 1, EPI_FFN1 = 2, EPI_E5 = 3, EPI_E5B = 4 };

template <int EPI>
DI void gemm_tile(const Params& p, const bf16_t* __restrict__ A, int lda, const bf16_t* __restrict__ Bt, int K, int tm, int tn, bf16_t* smem, float* s_aux) {
    const int tid = threadIdx.x, lane = tid & 63, w = tid >> 6, r = lane & 31, h = lane >> 5;
    const int wr = w >> 1, wc = w & 1;
    const int cc = tid & 7, r0 = tid >> 3;
    bf16_t* As = smem; bf16_t* Bs = smem + 2 * 128 * 72;

    if (EPI == EPI_E5B) {
        __syncthreads();
        if (tid < 128) {
            const int row = min(tm * 128 + tid, MT - 1); const int hd = tn >> 2;
            const float* pp = (const float*)((unsigned char*)p.out + OFFO_PART) + (size_t)row * 64 + hd * 16;
            float s = 0.f;
#pragma unroll
            for (int i = 0; i < 4; ++i) { const f32x4 v = *(const f32x4*)(pp + i * 4); s += (v[0] + v[1]) + (v[2] + v[3]); }
            s_aux[tid] = __frsqrt_rn(s * (1.0f / 512.0f) + 1e-6f);
        }
    }

    const bf16_t* ap[4]; const bf16_t* bp[4];
#pragma unroll
    for (int i = 0; i < 4; ++i) {
        const int ar = min(tm * 128 + r0 + 32 * i, MT - 1);
        ap[i] = A + (size_t)ar * lda + cc * 8;
        bp[i] = Bt + (size_t)(tn * 128 + r0 + 32 * i) * K + cc * 8;
    }
    f32x16 acc[2][2];
#pragma unroll
    for (int i = 0; i < 2; ++i)
#pragma unroll
        for (int j = 0; j < 2; ++j) acc[i][j] = zero16();

    u32x4 ra[4], rb[4];
#pragma unroll
    for (int i = 0; i < 4; ++i) { ra[i] = *(const u32x4*)(ap[i]); rb[i] = *(const u32x4*)(bp[i]); }
#pragma unroll
    for (int i = 0; i < 4; ++i) { *(u32x4*)(As + (r0 + 32 * i) * 72 + cc * 8) = ra[i]; *(u32x4*)(Bs + (r0 + 32 * i) * 72 + cc * 8) = rb[i]; }
    __syncthreads();
    const int nk = K >> 6;
    for (int kt = 0; kt < nk; ++kt) {
        const int cur = kt & 1;
        if (kt + 1 < nk) {
#pragma unroll
            for (int i = 0; i < 4; ++i) { ra[i] = *(const u32x4*)(ap[i] + (kt + 1) * 64); rb[i] = *(const u32x4*)(bp[i] + (kt + 1) * 64); }
        }
        const bf16_t* a_s = As + cur * 128 * 72 + (wr * 64 + r) * 72 + h * 8;
        const bf16_t* b_s = Bs + cur * 128 * 72 + (wc * 64 + r) * 72 + h * 8;
#pragma unroll
        for (int s = 0; s < 4; ++s) {
            const bf16x8 a0 = *(const bf16x8*)(a_s + s * 16), a1 = *(const bf16x8*)(a_s + 32 * 72 + s * 16);
            const bf16x8 b0 = *(const bf16x8*)(b_s + s * 16), b1 = *(const bf16x8*)(b_s + 32 * 72 + s * 16);
            acc[0][0] = mfma32(a0, b0, acc[0][0]); acc[0][1] = mfma32(a0, b1, acc[0][1]);
            acc[1][0] = mfma32(a1, b0, acc[1][0]); acc[1][1] = mfma32(a1, b1, acc[1][1]);
        }
        if (kt + 1 < nk) {
            bf16_t* a_d = As + (cur ^ 1) * 128 * 72; bf16_t* b_d = Bs + (cur ^ 1) * 128 * 72;
#pragma unroll
            for (int i = 0; i < 4; ++i) { *(u32x4*)(a_d + (r0 + 32 * i) * 72 + cc * 8) = ra[i]; *(u32x4*)(b_d + (r0 + 32 * i) * 72 + cc * 8) = rb[i]; }
        }
        __syncthreads();
    }

#pragma unroll
    for (int i = 0; i < 2; ++i)
#pragma unroll
        for (int g = 0; g < 4; ++g) {
            const int row0 = tm * 128 + wr * 64 + i * 32 + 8 * g + 4 * h;
            if (row0 >= MT) continue;
            const int b = row0 / LT, pos = row0 - b * LT;
#pragma unroll
            for (int j = 0; j < 2; ++j) {
                const int col = tn * 128 + wc * 64 + j * 32 + r;
                float v[4];
#pragma unroll
                for (int e = 0; e < 4; ++e) v[e] = acc[i][j][4 * g + e];
                if (EPI == EPI_E1) {
                    const int seg = tn >> 2, cs = col & 511;
                    if (seg == 2 || seg == 5) {
                        bf16_t* vt = (bf16_t*)(p.ws + (seg == 2 ? OFF_VTA : OFF_VTB));
                        u32x2 wv; wv[0] = cvt_pk(v[0], v[1]); wv[1] = cvt_pk(v[2], v[3]);
                        *(u32x2*)(vt + (size_t)(b * 512 + cs) * LP + pos) = wv;
                    } else {
                        const int oc = (seg == 0 ? 0 : seg == 1 ? 512 : seg == 3 ? 1024 : 1536) + cs;
                        bf16_t* d = (bf16_t*)(p.ws + OFF_PQK) + (size_t)row0 * 2048 + oc;
#pragma unroll
                        for (int e = 0; e < 4; ++e) d[(size_t)e * 2048] = f2bf(v[e]);
                    }
                } else if (EPI == EPI_RESID) {
                    float* d = (float*)(p.ws + OFF_H) + (size_t)row0 * 1024 + col;
#pragma unroll
                    for (int e = 0; e < 4; ++e) d[(size_t)e * 1024] = ALPHA * d[(size_t)e * 1024] + v[e];
                } else if (EPI == EPI_FFN1) {
                    bf16_t* d = (bf16_t*)(p.ws + OFF_U) + (size_t)row0 * 4096 + col;
#pragma unroll
                    for (int e = 0; e < 4; ++e) { const float t = fmaxf(v[e], 0.f); d[(size_t)e * 4096] = f2bf(t * t); }
                } else if (EPI == EPI_E5) {
                    const int idx = (pos + 48) & 63;
                    if (tn < 8) {
                        const int hd = col >> 8;
                        const float lg = log2f(1.f - ex2(-5.f - (float)hd));
                        bf16_t* d = (bf16_t*)((unsigned char*)p.out + OFFO_QHAT) + (size_t)row0 * 1024 + col;
#pragma unroll
                        for (int e = 0; e < 4; ++e) d[(size_t)e * 1024] = f2bf(v[e] * ex2(lg * (float)(idx + e + 1)));
                    } else if (tn < 16) {
                        const int c = col - 1024, hd = c >> 8;
                        const float lg = log2f(1.f - ex2(-5.f - (float)hd));
                        bf16_t* d = (bf16_t*)(p.ws + OFF_KHAT) + (size_t)row0 * 1024 + c;
#pragma unroll
                        for (int e = 0; e < 4; ++e) { v[e] *= 0.0625f * ex2(lg * (float)(63 - idx - e)); d[(size_t)e * 1024] = f2bf(v[e]); }
                        u32x2 wv; wv[0] = cvt_pk(v[0], v[1]); wv[1] = cvt_pk(v[2], v[3]);
                        *(u32x2*)((bf16_t*)(p.ws + OFF_KHATT) + (size_t)(b * 1024 + c) * LR + pos + 48) = wv;
                    } else {
                        const int c = col - 2048;
                        u32x2 wv; wv[0] = cvt_pk(v[0], v[1]); wv[1] = cvt_pk(v[2], v[3]);
                        *(u32x2*)((bf16_t*)(p.ws + OFF_VT1) + (size_t)(b * 2048 + c) * LR + pos + 48) = wv;
                    }
                } else if (EPI == EPI_E5B) {
                    const u32x2 ov = *(const u32x2*)((const bf16_t*)(p.ws + OFF_VT1) + (size_t)(b * 2048 + col) * LR + pos + 48);
                    bf16_t* d = (bf16_t*)(p.ws + OFF_YB) + (size_t)row0 * 2048 + col;
#pragma unroll
                    for (int e = 0; e < 4; ++e) {
                        const unsigned ob = (e & 1) ? (ov[e >> 1] & 0xffff0000u) : (ov[e >> 1] << 16);
                        const float o = __uint_as_float(ob);
                        const float gte = v[e] / (1.f + __expf(-v[e]));
                        d[(size_t)e * 2048] = f2bf(gte * o * s_aux[wr * 64 + i * 32 + 8 * g + 4 * h + e]);
                    }
                }
            }
        }
}

template <int EPI>
DI void ph_gemm(const Params& p, const bf16_t* A, int lda, const bf16_t* Bt, int K, int ntn, bf16_t* smem, float* s_aux) {
    const int nitems = NTM * ntn;
    for (int it = blockIdx.x; it < nitems; it += gridDim.x) gemm_tile<EPI>(p, A, lda, Bt, K, it / ntn, it % ntn, smem, s_aux);
}

DI void ph_fb(const Params& p) {
    const int lane = threadIdx.x & 63;
    const int gw = blockIdx.x * 4 + (threadIdx.x >> 6), nw = gridDim.x * 4;
    const float* H = (const float*)(p.ws + OFF_H);
    float* LF = (float*)(p.ws + OFF_LOGF);
    for (int m = gw; m < MT; m += nw) {
        float a[8];
#pragma unroll
        for (int j = 0; j < 8; ++j) a[j] = 0.f;
#pragma unroll 4
        for (int i = 0; i < 16; ++i) {
            const int k = lane + 64 * i;
            const float hv = H[(size_t)m * 1024 + k];
            const f32x4 w0 = *(const f32x4*)(p.ew_in + (size_t)k * 3080 + 3072), w1 = *(const f32x4*)(p.ew_in + (size_t)k * 3080 + 3076);
            a[0] += hv * w0[0]; a[1] += hv * w0[1]; a[2] += hv * w0[2]; a[3] += hv * w0[3];
            a[4] += hv * w1[0]; a[5] += hv * w1[1]; a[6] += hv * w1[2]; a[7] += hv * w1[3];
        }
#pragma unroll
        for (int j = 0; j < 8; ++j)
            for (int o = 32; o > 0; o >>= 1) a[j] += __shfl_xor(a[j], o);
        if (lane < 8) {
            float v = a[0];
#pragma unroll
            for (int j = 1; j < 8; ++j) v = (lane == j) ? a[j] : v;
            const float xx = v + p.ef_bias[lane];
            const float ls = fminf(xx, 0.f) - log1pf(expf(-fabsf(xx)));
            const int b = m / LT, pos = m - b * LT;
            LF[(size_t)(b * 8 + lane) * LP + pos] = ls;
        }
    }
}

DI void ph_cumsum(const Params& p, bf16_t* smem) {
    float* sm = (float*)smem;
    const int tid = threadIdx.x;
    const float* LF = (const float*)(p.ws + OFF_LOGF);
    float* CF = (float*)(p.ws + OFF_CUMF);
    for (int it = blockIdx.x; it < 32; it += gridDim.x) {
        const float* src = LF + (size_t)it * LP; float* dst = CF + (size_t)it * LP;
        const int p0 = tid * 33;
        float s = 0.f;
        for (int i = 0; i < 33; ++i) { const int pos = p0 + i; if (pos < LT) s += src[pos]; }
        __syncthreads();
        sm[tid] = s;
        __syncthreads();
        float run = 0.f;
        for (int t = 0; t < tid; ++t) run += sm[t];
        for (int i = 0; i < 33; ++i) { const int pos = p0 + i; if (pos < LP) { if (pos < LT) run += src[pos]; dst[pos] = run * LOG2E; } }
    }
}

template <int DV, bool FOX>
DI void flash(f32x16 (&O)[DV / 32], const bf16_t* __restrict__ qptr, const bf16_t* __restrict__ kg, const bf16_t* __restrict__ vtg,
              int ntiles, int q, float slope2, const float* __restrict__ cum2, bf16_t* smem) {
    constexpr int NDT = DV / 32;
    constexpr int KS_ELEMS = 64 * 72, VS_ELEMS = DV * 72, BUF = KS_ELEMS + VS_ELEMS;
    const int tid = threadIdx.x, lane = tid & 63, r = lane & 31, h = lane >> 5;
    const int pr = perm23(r);
    const int cc = tid & 7, r0 = tid >> 3;
    bf16x8 qf[4];
#pragma unroll
    for (int ks = 0; ks < 4; ++ks) qf[ks] = *(const bf16x8*)(qptr + ks * 16 + h * 8);
    float m = -1e30f, l = 0.f;
#pragma unroll
    for (int dt = 0; dt < NDT; ++dt) O[dt] = zero16();
    const float cq = FOX ? cum2[min(q, LT - 1)] : 0.f;
    const int kend = FOX ? q + 1 : 16 + 64 * ((q + 48) >> 6);
    const float c1 = 0.125f * LOG2E;

    u32x4 kr[2], vr[NDT];
    {
#pragma unroll
        for (int i = 0; i < 2; ++i) { const int krow = min(r0 + 32 * i, LT - 1); kr[i] = *(const u32x4*)(kg + (size_t)krow * 2048 + cc * 8); }
#pragma unroll
        for (int i = 0; i < NDT; ++i) vr[i] = *(const u32x4*)(vtg + (size_t)(r0 + 32 * i) * LP + cc * 8);
#pragma unroll
        for (int i = 0; i < 2; ++i) *(u32x4*)(smem + (r0 + 32 * i) * 72 + cc * 8) = kr[i];
#pragma unroll
        for (int i = 0; i < NDT; ++i) *(u32x4*)(smem + KS_ELEMS + (r0 + 32 * i) * 72 + cc * 8) = vr[i];
    }
    __syncthreads();
    for (int kt = 0; kt < ntiles; ++kt) {
        const int cur = kt & 1;
        const bf16_t* Ks = smem + cur * BUF; const bf16_t* Vs = Ks + KS_ELEMS;
        f32x16 s[2];
#pragma unroll
        for (int sub = 0; sub < 2; ++sub) {
            s[sub] = zero16();
#pragma unroll
            for (int ks = 0; ks < 4; ++ks) {
                const bf16x8 a = *(const bf16x8*)(Ks + (sub * 32 + pr) * 72 + ks * 16 + h * 8);
                s[sub] = mfma32(a, qf[ks], s[sub]);
            }
        }
        const int kb = kt * 64;
        float mx = -INFINITY;
#pragma unroll
        for (int sub = 0; sub < 2; ++sub) {
#pragma unroll
            for (int i8 = 0; i8 < 2; ++i8) {
                const int k0 = kb + sub * 32 + 16 * i8 + 8 * h;
                float ck[8];
                if (FOX) {
                    const f32x4 c0 = *(const f32x4*)(cum2 + k0), c1v = *(const f32x4*)(cum2 + k0 + 4);
                    ck[0] = c0[0]; ck[1] = c0[1]; ck[2] = c0[2]; ck[3] = c0[3]; ck[4] = c1v[0]; ck[5] = c1v[1]; ck[6] = c1v[2]; ck[7] = c1v[3];
                }
#pragma unroll
                for (int e = 0; e < 8; ++e) {
                    const int k = k0 + e;
                    float t = s[sub][8 * i8 + e] * c1;
                    if (FOX) t += cq - ck[e];
                    else t -= slope2 * fabsf((float)(q - k));
                    t = (k < kend) ? t : -INFINITY;
                    s[sub][8 * i8 + e] = t;
                    mx = fmaxf(mx, t);
                }
            }
        }
        mx = fmaxf(mx, __shfl_xor(mx, 32));
        const float mn = fmaxf(m, mx);
        const float alpha = ex2(m - mn);
        m = mn;
        l *= alpha;
#pragma unroll
        for (int dt = 0; dt < NDT; ++dt)
#pragma unroll
            for (int i = 0; i < 16; ++i) O[dt][i] *= alpha;
#pragma unroll
        for (int sub = 0; sub < 2; ++sub)
#pragma unroll
            for (int i = 0; i < 16; ++i) { const float pv = ex2(s[sub][i] - mn); s[sub][i] = pv; l += pv; }
        bf16x8 pf[2][2];
        pf[0][0] = pack8<0>(s[0]); pf[0][1] = pack8<1>(s[0]); pf[1][0] = pack8<0>(s[1]); pf[1][1] = pack8<1>(s[1]);
        if (kt + 1 < ntiles) {
            const int kb1 = (kt + 1) * 64;
#pragma unroll
            for (int i = 0; i < 2; ++i) { const int krow = min(kb1 + r0 + 32 * i, LT - 1); kr[i] = *(const u32x4*)(kg + (size_t)krow * 2048 + cc * 8); }
#pragma unroll
            for (int i = 0; i < NDT; ++i) vr[i] = *(const u32x4*)(vtg + (size_t)(r0 + 32 * i) * LP + kb1 + cc * 8);
        }
#pragma unroll
        for (int dt = 0; dt < NDT; ++dt)
#pragma unroll
            for (int sub = 0; sub < 2; ++sub)
#pragma unroll
                for (int s2 = 0; s2 < 2; ++s2) {
                    const bf16x8 a = *(const bf16x8*)(Vs + (dt * 32 + r) * 72 + sub * 32 + 16 * s2 + 8 * h);
                    O[dt] = mfma32(a, pf[sub][s2], O[dt]);
                }
        if (kt + 1 < ntiles) {
            bf16_t* Kd = smem + (cur ^ 1) * BUF; bf16_t* Vd = Kd + KS_ELEMS;
#pragma unroll
            for (int i = 0; i < 2; ++i) *(u32x4*)(Kd + (r0 + 32 * i) * 72 + cc * 8) = kr[i];
#pragma unroll
            for (int i = 0; i < NDT; ++i) *(u32x4*)(Vd + (r0 + 32 * i) * 72 + cc * 8) = vr[i];
        }
        __syncthreads();
    }
    l += __shfl_xor(l, 32);
    const float inv = 1.0f / l;
#pragma unroll
    for (int dt = 0; dt < NDT; ++dt)
#pragma unroll
        for (int i = 0; i < 16; ++i) O[dt][i] *= inv;
}

DI void ph_attn(const Params& p, bf16_t* smem) {
    const int tid = threadIdx.x, lane = tid & 63, w = tid >> 6, r = lane & 31, h = lane >> 5;
    const bf16_t* PQK = (const bf16_t*)(p.ws + OFF_PQK);
    bf16_t* MIX = (bf16_t*)(p.ws + OFF_HB);
    const float lam = ((const float*)(p.ws + OFF_MISC))[0];
    for (int it = blockIdx.x; it < 65 * 48; it += gridDim.x) {
        const int qb = 64 - it / 48, rem = it % 48;
        const int q = qb * 128 + w * 32 + r;
        if (rem < 16) {
            const int b = rem >> 2, hd = rem & 3;
            const int ntiles = (min(LT, qb * 128 + 144) + 63) >> 6;
            const size_t qrow = (size_t)b * LT + min(q, LT - 1);
            const float slope2 = ex2(-2.f * (float)(hd + 1)) * LOG2E;
            const bf16_t* vt = (const bf16_t*)(p.ws + OFF_VTA) + (size_t)(b * 512 + hd * 128) * LP;
            f32x16 O0[4];
            float* scr = p.out + (size_t)blockIdx.x * 16384 + tid * 64;
            flash<128, false>(O0, PQK + qrow * 2048 + hd * 128, PQK + (size_t)b * LT * 2048 + 512 + hd * 128, vt, ntiles, q, slope2, nullptr, smem);
#pragma unroll
            for (int dt = 0; dt < 4; ++dt)
#pragma unroll
                for (int g = 0; g < 4; ++g) *(f32x4*)(scr + dt * 16 + 4 * g) = (f32x4){O0[dt][4 * g], O0[dt][4 * g + 1], O0[dt][4 * g + 2], O0[dt][4 * g + 3]};
            flash<128, false>(O0, PQK + qrow * 2048 + hd * 128 + 64, PQK + (size_t)b * LT * 2048 + 512 + hd * 128 + 64, vt, ntiles, q, slope2, nullptr, smem);
            float ss = 0.f;
#pragma unroll
            for (int dt = 0; dt < 4; ++dt)
#pragma unroll
                for (int g = 0; g < 4; ++g) {
                    const f32x4 pv = *(const f32x4*)(scr + dt * 16 + 4 * g);
#pragma unroll
                    for (int e = 0; e < 4; ++e) { const float o = pv[e] - lam * O0[dt][4 * g + e]; O0[dt][4 * g + e] = o; ss += o * o; }
                }
            ss += __shfl_xor(ss, 32);
            const float rn = __frsqrt_rn(ss * (1.0f / 128.0f) + 1e-6f) * 0.8f;
            if (q < LT) {
                bf16_t* d = MIX + qrow * 1024 + hd * 128;
#pragma unroll
                for (int dt = 0; dt < 4; ++dt)
#pragma unroll
                    for (int g = 0; g < 4; ++g) {
                        const int dv = dt * 32 + 8 * g + 4 * h;
                        const f32x4 gg = *(const f32x4*)(p.subln + dv);
                        u32x2 wv; wv[0] = cvt_pk(O0[dt][4 * g] * rn * gg[0], O0[dt][4 * g + 1] * rn * gg[1]);
                        wv[1] = cvt_pk(O0[dt][4 * g + 2] * rn * gg[2], O0[dt][4 * g + 3] * rn * gg[3]);
                        *(u32x2*)(d + dv) = wv;
                    }
            }
        } else {
            const int b = (rem - 16) >> 3, hf = (rem - 16) & 7;
            const int ntiles = (min(LT, qb * 128 + 128) + 63) >> 6;
            const size_t qrow = (size_t)b * LT + min(q, LT - 1);
            const bf16_t* vt = (const bf16_t*)(p.ws + OFF_VTB) + (size_t)(b * 512 + hf * 64) * LP;
            f32x16 O[2];
            flash<64, true>(O, PQK + qrow * 2048 + 1024 + hf * 64, PQK + (size_t)b * LT * 2048 + 1536 + hf * 64, vt, ntiles, q, 0.f,
                            (const float*)(p.ws + OFF_CUMF) + (size_t)(b * 8 + hf) * LP, smem);
            if (q < LT) {
                bf16_t* d = MIX + qrow * 1024 + 512 + hf * 64;
#pragma unroll
                for (int dt = 0; dt < 2; ++dt)
#pragma unroll
                    for (int g = 0; g < 4; ++g) {
                        const int dv = dt * 32 + 8 * g + 4 * h;
                        u32x2 wv; wv[0] = cvt_pk(O[dt][4 * g], O[dt][4 * g + 1]); wv[1] = cvt_pk(O[dt][4 * g + 2], O[dt][4 * g + 3]);
                        *(u32x2*)(d + dv) = wv;
                    }
            }
        }
    }
}

DI void ph_ln(const Params& p, int lnidx, bool last) {
    const int lane = threadIdx.x & 63;
    const int gw = blockIdx.x * 4 + (threadIdx.x >> 6), nw = gridDim.x * 4;
    float* H = (float*)(p.ws + OFF_H); bf16_t* HB = (bf16_t*)(p.ws + OFF_HB);
    const float* G = p.ln_g + (size_t)lnidx * 1024; const float* Bv = p.ln_b + (size_t)lnidx * 1024;
    for (int m = gw; m < MT; m += nw) {
        f32x4 v[4];
        float s = 0.f;
#pragma unroll
        for (int i = 0; i < 4; ++i) { v[i] = *(const f32x4*)(H + (size_t)m * 1024 + i * 256 + lane * 4); s += (v[i][0] + v[i][1]) + (v[i][2] + v[i][3]); }
        for (int o = 32; o > 0; o >>= 1) s += __shfl_xor(s, o);
        const float mu = s * (1.0f / 1024.0f);
        float qv = 0.f;
#pragma unroll
        for (int i = 0; i < 4; ++i)
#pragma unroll
            for (int e = 0; e < 4; ++e) { const float d = v[i][e] - mu; qv += d * d; }
        for (int o = 32; o > 0; o >>= 1) qv += __shfl_xor(qv, o);
        const float rstd = __frsqrt_rn(qv * (1.0f / 1024.0f) + 1e-5f);
        const int b = m / LT, pos = m - b * LT;
#pragma unroll
        for (int i = 0; i < 4; ++i) {
            const int c = i * 256 + lane * 4;
            const f32x4 g = *(const f32x4*)(G + c), bb = *(const f32x4*)(Bv + c);
            f32x4 y;
#pragma unroll
            for (int e = 0; e < 4; ++e) y[e] = (v[i][e] - mu) * rstd * g[e] + bb[e];
            if (last) {
                if (pos >= 16) *(f32x4*)(p.out + ((size_t)b * 8192 + (pos - 16)) * 1024 + c) = y;
            } else {
                *(f32x4*)(H + (size_t)m * 1024 + c) = y;
                u32x2 wv; wv[0] = cvt_pk(y[0], y[1]); wv[1] = cvt_pk(y[2], y[3]);
                *(u32x2*)(HB + (size_t)m * 1024 + c) = wv;
            }
        }
    }
}

DI void ph_zero_ret_pads(const Params& p) {
    const int tid = threadIdx.x;
    for (int idx = blockIdx.x * 256 + tid; idx < (4096 + 8192) * 6; idx += gridDim.x * 256) {
        const int row = idx / 6, c = idx % 6;
        bf16_t* base = row < 4096 ? (bf16_t*)(p.ws + OFF_KHATT) + (size_t)row * LR : (bf16_t*)(p.ws + OFF_VT1) + (size_t)(row - 4096) * LR;
        *(u32x4*)(base + c * 8) = (u32x4){0u, 0u, 0u, 0u};
    }
}

DI void ph_sprep(const Params& p) {
    const int tid = threadIdx.x, lane = tid & 63, w = tid >> 6, r = lane & 31, h = lane >> 5;
    const int it_ = w >> 1, jt = w & 1;
    const bf16_t* QH = (const bf16_t*)((unsigned char*)p.out + OFFO_QHAT);
    const bf16_t* KH = (const bf16_t*)(p.ws + OFF_KHAT);
    bf16_t* SB = (bf16_t*)((unsigned char*)p.out + OFFO_SBUF);
    for (int item = blockIdx.x; item < NCH * 16; item += gridDim.x) {
        const int c = item >> 4, b = (item >> 2) & 3, hd = item & 3;
        const int ppi = c * 64 + it_ * 32 + r, ppj = c * 64 + jt * 32 + r;
        const bool vi = ppi >= 48, vj = ppj >= 48;
        const bf16_t* qp = QH + ((size_t)b * LT + (vi ? ppi - 48 : 0)) * 1024 + hd * 256 + h * 8;
        const bf16_t* kp = KH + ((size_t)b * LT + (vj ? ppj - 48 : 0)) * 1024 + hd * 256 + h * 8;
        f32x16 acc = zero16();
        const bf16x8 z8 = {0, 0, 0, 0, 0, 0, 0, 0};
#pragma unroll 4
        for (int s = 0; s < 16; ++s) {
            bf16x8 a = *(const bf16x8*)(qp + s * 16), bq = *(const bf16x8*)(kp + s * 16);
            if (!vi) a = z8;
            if (!vj) bq = z8;
            acc = mfma32(a, bq, acc);
        }
        const float lg = log2f(1.f - ex2(-5.f - (float)hd));
        bf16_t* d = SB + (size_t)item * 4096;
        const int j = jt * 32 + r;
#pragma unroll
        for (int reg = 0; reg < 16; ++reg) {
            const int i = it_ * 32 + crow(reg, h);
            const int e = (i >= j) ? -64 : 2 * (j - i) - 64;
            d[i * 64 + j] = f2bf(acc[reg] * ex2(lg * (float)e));
        }
    }
}

template <int T>
DI void scan_inter(f32x16 (&o)[2], const f32x16& st, const bf16_t* q0, const bf16_t* q1, bool v0, bool v1) {
    const bf16x8 z8 = {0, 0, 0, 0, 0, 0, 0, 0};
    {
        const bf16x8 a = pack8<0>(st);
        bf16x8 b0 = *(const bf16x8*)(q0 + T * 32), b1 = *(const bf16x8*)(q1 + T * 32);
        if (!v0) b0 = z8;
        if (!v1) b1 = z8;
        o[0] = mfma32(a, b0, o[0]); o[1] = mfma32(a, b1, o[1]);
    }
    {
        const bf16x8 a = pack8<1>(st);
        bf16x8 b0 = *(const bf16x8*)(q0 + T * 32 + 16), b1 = *(const bf16x8*)(q1 + T * 32 + 16);
        if (!v0) b0 = z8;
        if (!v1) b1 = z8;
        o[0] = mfma32(a, b0, o[0]); o[1] = mfma32(a, b1, o[1]);
    }
}

DI void scan_unit(const Params& p, int u) {
    const int lane = threadIdx.x & 63, r = lane & 31, h = lane >> 5;
    const int sl = u & 15, hd = (u >> 4) & 3, b = u >> 6;
    const float lg = log2f(1.f - ex2(-5.f - (float)hd));
    const float cdec = ex2(lg * 64.f);
    const int pr = perm23(r);
    const bf16_t* ktb = (const bf16_t*)(p.ws + OFF_KHATT) + (size_t)(b * 1024 + hd * 256 + pr) * LR + h * 8;
    bf16_t* vrow = (bf16_t*)(p.ws + OFF_VT1) + (size_t)(b * 2048 + hd * 512 + sl * 32 + r) * LR + h * 8;
    bf16_t* ob = (bf16_t*)(p.ws + OFF_VT1) + (size_t)(b * 2048 + hd * 512 + sl * 32) * LR;
    const bf16_t* QH = (const bf16_t*)((unsigned char*)p.out + OFFO_QHAT);
    const bf16_t* SB = (const bf16_t*)((unsigned char*)p.out + OFFO_SBUF);
    float* PART = (float*)((unsigned char*)p.out + OFFO_PART);
    f32x16 st[8];
#pragma unroll
    for (int t = 0; t < 8; ++t) st[t] = zero16();
    for (int c = 0; c < NCH; ++c) {
        bf16x8 vf[4];
#pragma unroll
        for (int s = 0; s < 4; ++s) vf[s] = *(const bf16x8*)(vrow + c * 64 + 16 * s);
        f32x16 o[2]; o[0] = zero16(); o[1] = zero16();
        const bf16_t* sb = SB + (size_t)((c * 4 + b) * 4 + hd) * 4096 + r * 64 + h * 8;
#pragma unroll
        for (int s = 0; s < 4; ++s) {
            const bf16x8 b0 = *(const bf16x8*)(sb + 16 * s), b1 = *(const bf16x8*)(sb + 32 * 64 + 16 * s);
            o[0] = mfma32(vf[s], b0, o[0]); o[1] = mfma32(vf[s], b1, o[1]);
        }
        const int pp0 = c * 64 + r, pp1 = pp0 + 32;
        const bool v0 = pp0 >= 48, v1 = pp1 >= 48;
        const size_t m0 = (size_t)b * LT + (v0 ? pp0 - 48 : 0), m1 = (size_t)b * LT + (v1 ? pp1 - 48 : 0);
        const bf16_t* q0 = QH + m0 * 1024 + hd * 256 + h * 8;
        const bf16_t* q1 = QH + m1 * 1024 + hd * 256 + h * 8;
        scan_inter<0>(o, st[0], q0, q1, v0, v1); scan_inter<1>(o, st[1], q0, q1, v0, v1);
        scan_inter<2>(o, st[2], q0, q1, v0, v1); scan_inter<3>(o, st[3], q0, q1, v0, v1);
        scan_inter<4>(o, st[4], q0, q1, v0, v1); scan_inter<5>(o, st[5], q0, q1, v0, v1);
        scan_inter<6>(o, st[6], q0, q1, v0, v1); scan_inter<7>(o, st[7], q0, q1, v0, v1);
#pragma unroll
        for (int it = 0; it < 2; ++it) {
            float ss = 0.f;
#pragma unroll
            for (int reg = 0; reg < 16; ++reg) {
                const float v = o[it][reg]; ss += v * v;
                ob[(size_t)crow(reg, h) * LR + c * 64 + it * 32 + r] = f2bf(v);
            }
            ss += __shfl_xor(ss, 32);
            const bool vv = it ? v1 : v0; const size_t mm = it ? m1 : m0;
            if (h == 0 && vv) PART[mm * 64 + hd * 16 + sl] = ss;
        }
#pragma unroll
        for (int t = 0; t < 8; ++t) {
#pragma unroll
            for (int i = 0; i < 16; ++i) st[t][i] *= cdec;
#pragma unroll
            for (int s = 0; s < 4; ++s) {
                const bf16x8 ka = *(const bf16x8*)(ktb + (size_t)t * 32 * LR + c * 64 + 16 * s);
                st[t] = mfma32(ka, vf[s], st[t]);
            }
        }
    }
}

DI void ph_scan(const Params& p) {
    if (threadIdx.x < 64)
        for (int u = blockIdx.x; u < 256; u += gridDim.x) scan_unit(p, u);
}

constexpr int NPHASE = 18;
template <int ph>
DI void run_phase(const Params& p, bf16_t* smem, float* s_aux) {
    const bf16_t* HB = (const bf16_t*)(p.ws + OFF_HB);
    switch (ph) {
        case 0: ph_prologue(p, smem); break;
        case 1: ph_gemm<EPI_E1>(p, HB, 1024, (const bf16_t*)(p.ws + OFF_W0IN), 1024, 24, smem, s_aux); ph_fb(p); break;
        case 2: ph_cumsum(p, smem); break;
        case 3: ph_attn(p, smem); break;
        case 4: ph_gemm<EPI_RESID>(p, HB, 1024, (const bf16_t*)(p.ws + OFF_W0OUT), 1024, 8, smem, s_aux); break;
        case 5: ph_ln(p, 0, false); break;
        case 6: ph_gemm<EPI_FFN1>(p, HB, 1024, (const bf16_t*)(p.ws + OFF_F1), 1024, 32, smem, s_aux); break;
        case 7: ph_gemm<EPI_RESID>(p, (const bf16_t*)(p.ws + OFF_U), 4096, (const bf16_t*)(p.ws + OFF_F2), 4096, 8, smem, s_aux); break;
        case 8: ph_ln(p, 1, false); break;
        case 9: ph_zero_ret_pads(p); ph_gemm<EPI_E5>(p, HB, 1024, (const bf16_t*)(p.ws + OFF_W1IN), 1024, 32, smem, s_aux); break;
        case 10: ph_sprep(p); break;
        case 11: ph_scan(p); break;
        case 12: ph_gemm<EPI_E5B>(p, HB, 1024, (const bf16_t*)(p.ws + OFF_W1IN) + (size_t)4096 * 1024, 1024, 16, smem, s_aux); break;
        case 13: ph_gemm<EPI_RESID>(p, (const bf16_t*)(p.ws + OFF_YB), 2048, (const bf16_t*)(p.ws + OFF_W1OUT), 2048, 8, smem, s_aux); break;
        case 14: ph_ln(p, 2, false); break;
        case 15: ph_gemm<EPI_FFN1>(p, HB, 1024, (const bf16_t*)(p.ws + OFF_F1 + SZ_F), 1024, 32, smem, s_aux); break;
        case 16: ph_gemm<EPI_RESID>(p, (const bf16_t*)(p.ws + OFF_U), 4096, (const bf16_t*)(p.ws + OFF_F2 + SZ_F), 4096, 8, smem, s_aux); break;
        case 17: ph_ln(p, 3, true); break;
    }
}

template <int PH>
__global__ void __launch_bounds__(256, 2) k_phase(Params p) {
    __shared__ __attribute__((aligned(16))) bf16_t smem[SMEM_ELEMS];
    __shared__ float s_aux[128];
    run_phase<PH>(p, smem, s_aux);
}

__global__ void __launch_bounds__(256, 2) k_mega(Params p) {
    __shared__ __attribute__((aligned(16))) bf16_t smem[SMEM_ELEMS];
    __shared__ float s_aux[128];
    cg::grid_group grid = cg::this_grid();
#define PHS(N) run_phase<N>(p, smem, s_aux); grid.sync();
    PHS(0) PHS(1) PHS(2) PHS(3) PHS(4) PHS(5) PHS(6) PHS(7) PHS(8) PHS(9) PHS(10) PHS(11) PHS(12) PHS(13) PHS(14) PHS(15) PHS(16)
    run_phase<17>(p, smem, s_aux);
}

extern "C" void kernel_launch(void* const* d_in, const int* in_sizes, int n_in, void* d_out, int out_size, void* d_ws, size_t ws_size, hipStream_t stream) {
    Params p{};
    p.x = (const float*)d_in[0]; p.meta = (const float*)d_in[1]; p.ew_in = (const float*)d_in[2]; p.ef_bias = (const float*)d_in[3];
    p.dlam = (const float*)d_in[4]; p.subln = (const float*)d_in[5]; p.ew_out = (const float*)d_in[6]; p.rw_in = (const float*)d_in[7];
    p.rw_out = (const float*)d_in[8]; p.ln_g = (const float*)d_in[9]; p.ln_b = (const float*)d_in[10]; p.f_w1 = (const float*)d_in[11];
    p.f_w2 = (const float*)d_in[12]; p.out = (float*)d_out; p.ws = (unsigned char*)d_ws;
    if (ws_size < WS_END) { fprintf(stderr, "workspace too small: %zu < %zu\n", ws_size, (size_t)WS_END); }
    static int grid_blocks = 0;
    if (!grid_blocks) {
        int dev = 0, cus = 0, per_cu = 0;
        hipGetDevice(&dev);
        hipDeviceGetAttribute(&cus, hipDeviceAttributeMultiprocessorCount, dev);
#if MEGA
        hipOccupancyMaxActiveBlocksPerMultiprocessor(&per_cu, k_mega, 256, 0);
#else
        hipOccupancyMaxActiveBlocksPerMultiprocessor(&per_cu, k_phase<3>, 256, 0);
#endif
        if (per_cu < 1) per_cu = 1;
        if (per_cu > 2) per_cu = 2;
        grid_blocks = cus * per_cu;
    }
#if MEGA
    void* args[] = {&p};
    hipError_t e = hipLaunchCooperativeKernel((void*)k_mega, dim3(grid_blocks), dim3(256), args, 0, stream);
    if (e != hipSuccess) fprintf(stderr, "cooperative launch failed: %s (grid %d)\n", hipGetErrorString(e), grid_blocks);
#else
#define LPH(N) k_phase<N><<<grid_blocks, 256, 0, stream>>>(p);
    LPH(0) LPH(1) LPH(2) LPH(3) LPH(4) LPH(5) LPH(6) LPH(7) LPH(8) LPH(9) LPH(10) LPH(11) LPH(12) LPH(13) LPH(14) LPH(15) LPH(16) LPH(17)
#endif
}
```

```cpp
#include <hip/hip_runtime.h>
#include <hip/hip_cooperative_groups.h>
#include <cstdio>
#include <cstdint>
namespace cg = cooperative_groups;

#ifndef MEGA
#define MEGA 1
#endif

#define DI __device__ __forceinline__
typedef unsigned short bf16_t;
typedef __attribute__((ext_vector_type(8))) short bf16x8;
typedef __attribute__((ext_vector_type(16))) float f32x16;
typedef __attribute__((ext_vector_type(4))) float f32x4;
typedef __attribute__((ext_vector_type(2))) float f32x2;
typedef __attribute__((ext_vector_type(2))) __bf16 bf16x2v;
typedef __attribute__((ext_vector_type(4))) unsigned u32x4;
typedef __attribute__((ext_vector_type(2))) unsigned u32x2;

constexpr int BATCH = 4, LT = 8208, MT = BATCH * LT  , LP = 8320, LR = 8256, DM = 1024;
constexpr int NTM = (MT + 127) / 128;
constexpr int NCH = 129;
constexpr float LOG2E = 1.4426950408889634f;
constexpr float ALPHA = 1.4142135623730951f;

constexpr size_t SZ_W0IN = 3072ull * 1024 * 2, SZ_W0OUT = 1024ull * 1024 * 2, SZ_W1IN = 6144ull * 1024 * 2, SZ_W1OUT = 1024ull * 2048 * 2, SZ_F = 4096ull * 1024 * 2;
constexpr size_t OFF_W0IN = 0;
constexpr size_t OFF_W0OUT = OFF_W0IN + SZ_W0IN;
constexpr size_t OFF_W1IN = OFF_W0OUT + SZ_W0OUT;
constexpr size_t OFF_W1OUT = OFF_W1IN + SZ_W1IN;
constexpr size_t OFF_F1 = OFF_W1OUT + SZ_W1OUT;
constexpr size_t OFF_F2 = OFF_F1 + 2 * SZ_F;
constexpr size_t OFF_H = OFF_F2 + 2 * SZ_F;
constexpr size_t OFF_HB = OFF_H + (size_t)MT * 1024 * 4;
constexpr size_t OFF_LOGF = OFF_HB + (size_t)MT * 1024 * 2;
constexpr size_t OFF_CUMF = OFF_LOGF + (size_t)BATCH * 8 * LP * 4;
constexpr size_t OFF_MISC = OFF_CUMF + (size_t)BATCH * 8 * LP * 4;
constexpr size_t OFF_BAR = OFF_MISC + 4096;
constexpr size_t OFF_CNT = OFF_BAR + 16384;
constexpr size_t OFF_R = OFF_MISC + 32768;
constexpr size_t OFF_PQK = OFF_R;
constexpr size_t OFF_VTA = OFF_PQK + (size_t)MT * 2048 * 2;
constexpr size_t OFF_VTB = OFF_VTA + (size_t)BATCH * 512 * LP * 2;
constexpr size_t OFF_U = OFF_R;
constexpr size_t OFF_KHAT = OFF_R;
constexpr size_t OFF_KHATT = OFF_KHAT + (size_t)MT * 1024 * 2;
constexpr size_t OFF_VT1 = OFF_KHATT + (size_t)BATCH * 1024 * LR * 2;
constexpr size_t OFF_YB = OFF_KHAT;
constexpr size_t WS_END = OFF_VT1 + (size_t)BATCH * 2048 * LR * 2;
static_assert(OFF_U + (size_t)MT * 4096 * 2 <= WS_END + 4000000, "ws");
static_assert(WS_END <= 536870912ull, "ws too big");
static_assert((size_t)MT * 2048 * 2 <= (OFF_VT1 - OFF_KHAT), "yb alias");
constexpr size_t OFFO_QHAT = 0;
constexpr size_t OFFO_SBUF = OFFO_QHAT + (size_t)NCH * 16 * 64 * 256 * 2;
constexpr size_t OFFO_PART = OFFO_SBUF + (size_t)NCH * 16 * 4096 * 2;
constexpr size_t OFFO_DUMMY = OFFO_PART + (size_t)MT * 256 * 4;
static_assert(OFFO_DUMMY + 256 * 512 * 4 <= 124ull * 1048576, "out scratch");
constexpr size_t OFFO_STATS = 124ull * 1048576;
static_assert(OFFO_STATS + (size_t)MT * 8 <= 134217728ull, "out scratch");

struct Params {
    const float *x, *meta, *ew_in, *ef_bias, *dlam, *subln, *ew_out, *rw_in, *rw_out, *ln_g, *ln_b, *f_w1, *f_w2;
    float* out;
    unsigned char* ws;
};

DI unsigned cvt_pk(float lo, float hi) { f32x2 v = {lo, hi}; bf16x2v b = __builtin_convertvector(v, bf16x2v); return __builtin_bit_cast(unsigned, b); }
DI bf16_t f2bf(float x) { return (bf16_t)(cvt_pk(x, 0.f) & 0xffffu); }
DI f32x16 mfma32(bf16x8 a, bf16x8 b, f32x16 c) { return __builtin_amdgcn_mfma_f32_32x32x16_bf16(a, b, c, 0, 0, 0); }
DI int crow(int reg, int h) { return (reg & 3) + 8 * (reg >> 2) + 4 * h; }
DI int perm23(int r) { return (r & 0x13) | ((r & 4) << 1) | ((r & 8) >> 1); }
template <int S> DI bf16x8 pack8(const f32x16& x) {
    u32x4 p;
    p[0] = cvt_pk(x[8 * S + 0], x[8 * S + 1]); p[1] = cvt_pk(x[8 * S + 2], x[8 * S + 3]);
    p[2] = cvt_pk(x[8 * S + 4], x[8 * S + 5]); p[3] = cvt_pk(x[8 * S + 6], x[8 * S + 7]);
    return __builtin_bit_cast(bf16x8, p);
}
DI f32x16 zero16() { f32x16 z; for (int i = 0; i < 16; ++i) z[i] = 0.f; return z; }
DI float ex2(float x) { return __builtin_amdgcn_exp2f(x); }
DI float xsum32(float x) { auto r = __builtin_amdgcn_permlane32_swap(__float_as_uint(x), __float_as_uint(x), false, false); return __uint_as_float(r[0]) + __uint_as_float(r[1]); }
DI float xmax32(float x) { auto r = __builtin_amdgcn_permlane32_swap(__float_as_uint(x), __float_as_uint(x), false, false); return fmaxf(__uint_as_float(r[0]), __uint_as_float(r[1])); }
DI int opaque_tid() { int t = threadIdx.x; asm volatile("" : "+v"(t)); return t; }


#define XB_TMO      128
#define XB_XCNT(j)  (256  + 64 * (j))
#define XB_XSUB(j)  (1280 + 64 * (j))
#define XB_XGEN(j)  (2304 + 64 * (j))
#define XB_TOP      3328
#define XB_TOPGEN   3392
#define XCD_BAR_WORDS 3456
#define XB_SPIN_CAP (1u << 20)
#define LAS __attribute__((address_space(3)))
DI unsigned xb_ld(unsigned* p) { return __hip_atomic_load(p, __ATOMIC_RELAXED, __HIP_MEMORY_SCOPE_AGENT); }
DI unsigned xb_add(unsigned* p, unsigned v) { return __hip_atomic_fetch_add(p, v, __ATOMIC_RELAXED, __HIP_MEMORY_SCOPE_AGENT); }
DI unsigned xb_xcc_id() { return (unsigned)__builtin_amdgcn_s_getreg((3 << 11) | 20) & 0xFu; }
#define XB_SPIN(cond, bar) do { unsigned _sp = 0; while (cond) { __builtin_amdgcn_s_sleep(1); \
    if ((++_sp & 255u) == 0u) { if (xb_ld(&(bar)[XB_TMO])) break; if (_sp > XB_SPIN_CAP) { atomicAdd(&(bar)[XB_TMO], 1u); break; } } } } while (0)
struct XcdBarrier { unsigned* bar; unsigned x; volatile LAS unsigned* st; };
DI XcdBarrier xcd_barrier_post(unsigned* bar, volatile LAS unsigned* st) {
    XcdBarrier b; b.bar = bar; b.x = xb_xcc_id(); b.st = st;
    if (opaque_tid() == 0) (void)xb_add(&bar[XB_XCNT(b.x)], 1u);
    return b;
}
DI void xcd_barrier_complete(unsigned* bar, unsigned x, unsigned& nloc, unsigned& nx) {
    const unsigned G = gridDim.x * gridDim.y * gridDim.z;
    unsigned sum, cnt, mine, sp = 0u;
    for (;;) {
        sum = 0u; cnt = 0u; mine = 0u;
#pragma unroll
        for (unsigned j = 0; j < 16; ++j) { const unsigned c = xb_ld(&bar[XB_XCNT(j)]); sum += c; cnt += (c > 0u) ? 1u : 0u; mine = (j == x) ? c : mine; }
        if (sum == G) break;
        __builtin_amdgcn_s_sleep(1);
        if ((++sp & 255u) == 0u) { if (xb_ld(&bar[XB_TMO])) break; if (sp > XB_SPIN_CAP) { atomicAdd(&bar[XB_TMO], 1u); break; } }
    }
    nloc = mine > 0u ? mine : 1u; nx = cnt > 0u ? cnt : 1u;
}
DI void xcd_barrier(const XcdBarrier& b) {
    asm volatile("s_waitcnt vmcnt(0)" ::: "memory");
    __syncthreads();
    if (opaque_tid() == 0) {
        unsigned* bar = b.bar;
        __builtin_amdgcn_s_waitcnt(0);
        unsigned nloc = b.st[0], nx = b.st[1];
        if (nloc == 0u) { xcd_barrier_complete(bar, b.x, nloc, nx); b.st[0] = nloc; b.st[1] = nx; }
        const unsigned old = xb_add(&bar[XB_XSUB(b.x)], 1u);
        const unsigned gen = old / nloc;
        if (old + 1u == (gen + 1u) * nloc) {
            __builtin_amdgcn_fence(__ATOMIC_RELEASE, "agent");
            asm volatile("s_waitcnt vmcnt(0)" ::: "memory");
            const unsigned og = xb_add(&bar[XB_TOP], 1u);
            const unsigned tg = og / nx;
            if (og + 1u == (tg + 1u) * nx) xb_add(&bar[XB_TOPGEN], 1u);
            else XB_SPIN(xb_ld(&bar[XB_TOPGEN]) == tg, bar);
            __builtin_amdgcn_fence(__ATOMIC_ACQUIRE, "agent");
            xb_add(&bar[XB_XGEN(b.x)], 1u);
            asm volatile("s_waitcnt vmcnt(0)" ::: "memory");
        } else {
            XB_SPIN(xb_ld(&bar[XB_XGEN(b.x)]) == gen, bar);
            __builtin_amdgcn_fence(__ATOMIC_ACQUIRE, "agent");
            asm volatile("s_waitcnt vmcnt(0)" ::: "memory");
        }
    }
    __syncthreads();
}


DI size_t qf_off(int item, int i, int dk) { return ((size_t)(((item * 8 + (dk >> 5)) * 2 + ((dk >> 4) & 1)) * 2 + (i >> 5)) * 64 + ((dk >> 3) & 1) * 32 + (i & 31)) * 8 + (dk & 7); }
DI size_t kf_off(int item, int dk, int j) { return ((size_t)((item * 8 + (dk >> 5)) * 4 + (j >> 4)) * 64 + ((j >> 3) & 1) * 32 + perm23(dk & 31)) * 8 + (j & 7); }
DI size_t vf_off(int item, int dvh, int j) { return ((size_t)((item * 16 + (dvh >> 5)) * 4 + (j >> 4)) * 64 + ((j >> 3) & 1) * 32 + (dvh & 31)) * 8 + (j & 7); }
DI size_t sf_off(int item, int i, int j) { return ((size_t)((item * 2 + (i >> 5)) * 4 + (j >> 4)) * 64 + ((j >> 3) & 1) * 32 + (i & 31)) * 8 + (j & 7); }

constexpr int NT = 512;
constexpr int SMEM_BYTES = 131072;
constexpr int DSM_BYTES = SMEM_BYTES + 4096 + 8192;
extern __shared__ __attribute__((aligned(16))) unsigned char dsm[];

DI void transpose_tile(const float* __restrict__ src, int ld, bf16_t* __restrict__ dst, int K, int k0, int n0, float* tile) {
    const int tid = opaque_tid();
#pragma unroll 4
    for (int i = 0; i < 8; ++i) { const int k = (tid >> 6) + 8 * i, n = tid & 63; tile[k * 65 + n] = src[(size_t)(k0 + k) * ld + n0 + n]; }
    __syncthreads();
#pragma unroll 4
    for (int i = 0; i < 8; ++i) { const int n = (tid >> 6) + 8 * i, k = tid & 63; dst[(size_t)(n0 + n) * K + k0 + k] = f2bf(tile[k * 65 + n]); }
    __syncthreads();
}

DI void ph_prologue(const Params& p, bf16_t* smem) {
    float* tile = (float*)smem;
    const int tid = opaque_tid();
    auto decode = [&](int it, const float*& sp, bf16_t*& dp, int& ld, int& K) {
        const float* src; int N; bf16_t* dst; int t = it;
        if (t < 768) { src = p.ew_in; ld = 3080; K = 1024; N = 3072; dst = (bf16_t*)(p.ws + OFF_W0IN); }
        else if ((t -= 768) < 256) { src = p.ew_out; ld = 1024; K = 1024; N = 1024; dst = (bf16_t*)(p.ws + OFF_W0OUT); }
        else if ((t -= 256) < 1536) { src = p.rw_in; ld = 6144; K = 1024; N = 6144; dst = (bf16_t*)(p.ws + OFF_W1IN); }
        else if ((t -= 1536) < 512) { src = p.rw_out; ld = 1024; K = 2048; N = 1024; dst = (bf16_t*)(p.ws + OFF_W1OUT); }
        else if ((t -= 512) < 2048) { const int l = t >> 10; t &= 1023; src = p.f_w1 + (size_t)l * 1024 * 4096; ld = 4096; K = 1024; N = 4096; dst = (bf16_t*)(p.ws + OFF_F1 + l * SZ_F); }
        else { t -= 2048; const int l = t >> 10; t &= 1023; src = p.f_w2 + (size_t)l * 4096 * 1024; ld = 1024; K = 4096; N = 1024; dst = (bf16_t*)(p.ws + OFF_F2 + l * SZ_F); }
        const int ntn = N >> 6, k0 = (t / ntn) * 64, n0 = (t % ntn) * 64;
        sp = src + (size_t)k0 * ld + n0;
        dp = dst + (size_t)n0 * K + k0;
    };
    {
        const int tr = tid >> 6, tc = tid & 63;
        int it = blockIdx.x;
        const float* sp = nullptr; bf16_t* dp = nullptr; int ld = 0, K = 0;
        float pre[8];
        if (it < 7168) {
            decode(it, sp, dp, ld, K);
#pragma unroll
            for (int i = 0; i < 8; ++i) pre[i] = sp[(size_t)(tr + 8 * i) * ld + tc];
        }
        while (it < 7168) {
#pragma unroll
            for (int i = 0; i < 8; ++i) tile[(tr + 8 * i) * 65 + tc] = pre[i];
            __syncthreads();
            bf16_t* dcur = dp; const int Kcur = K;
            const int itn = it + (int)gridDim.x;
            if (itn < 7168) {
                decode(itn, sp, dp, ld, K);
#pragma unroll
                for (int i = 0; i < 8; ++i) pre[i] = sp[(size_t)(tr + 8 * i) * ld + tc];
            }
#pragma unroll
            for (int i = 0; i < 8; ++i) dcur[(size_t)(tr + 8 * i) * Kcur + tc] = f2bf(tile[tc * 65 + tr + 8 * i]);
            __syncthreads();
            it = itn;
        }
    }
    bf16_t* VT = (bf16_t*)(p.ws + OFF_VTA);
    for (int idx = blockIdx.x * NT + tid; idx < 4096 * 6; idx += gridDim.x * NT) {
        const int row = idx / 6, c = idx % 6;
        *(u32x4*)(VT + ((size_t)128 * 4096 + row) * 64 + 16 + c * 8) = (u32x4){0u, 0u, 0u, 0u};
    }
    if (blockIdx.x == 0 && tid < 64) {
        float a = p.dlam[tid] * p.dlam[64 + tid], b = p.dlam[128 + tid] * p.dlam[192 + tid];
        for (int o = 32; o > 0; o >>= 1) { a += __shfl_xor(a, o); b += __shfl_xor(b, o); }
        if (tid == 0) ((float*)(p.ws + OFF_MISC))[0] = __expf(a) - __expf(b) + 0.2f;
    }
}

enum { EPI_E1 = 0, EPI_RESID = 1, EPI_FFN1 = 2, EPI_E5 = 3, EPI_E5B = 4 };

template <int EPI, int LNI = -1>
DI void epi_store(const Params& p, int row0, int col, int lrow0, float (&v)[4], const float* s_aux, const f32x2* rs = nullptr, float gg = 1.f, float bb = 0.f) {
    const int b = row0 / LT, pos = row0 - b * LT;
    if (EPI == EPI_E1) {
        const int seg = col >> 9, cs = col & 511;
        if (seg == 2 || seg == 5) {
            bf16_t* vt = (bf16_t*)(p.ws + OFF_VTA);
            u32x2 wv; wv[0] = cvt_pk(v[0], v[1]); wv[1] = cvt_pk(v[2], v[3]);
            *(u32x2*)(vt + ((size_t)(pos >> 6) * 4096 + (seg == 2 ? 0 : 2048) + b * 512 + cs) * 64 + (pos & 63)) = wv;
        } else {
            const int oc = (seg == 0 ? 0 : seg == 1 ? 512 : seg == 3 ? 1024 : 1536) + cs;
            bf16_t* d = (bf16_t*)(p.ws + OFF_PQK) + (size_t)row0 * 2048 + oc;
#pragma unroll
            for (int e = 0; e < 4; ++e) d[(size_t)e * 2048] = f2bf(v[e]);
        }
    } else if (EPI == EPI_RESID) {
        float* d = (float*)(p.ws + OFF_H) + (size_t)row0 * 1024 + col;
#pragma unroll
        for (int e = 0; e < 4; ++e) {
            float hprev = d[(size_t)e * 1024];
            if (LNI >= 0) hprev = (hprev - rs[e][0]) * rs[e][1] * gg + bb;
            d[(size_t)e * 1024] = ALPHA * hprev + v[e];
        }
    } else if (EPI == EPI_FFN1) {
        bf16_t* d = (bf16_t*)(p.ws + OFF_U) + (size_t)row0 * 4096 + col;
#pragma unroll
        for (int e = 0; e < 4; ++e) { const float t = fmaxf(v[e], 0.f); d[(size_t)e * 4096] = f2bf(t * t); }
    } else if (EPI == EPI_E5) {
        const int idx = (pos + 48) & 63, ch = (pos + 48) >> 6;
        if (col < 1024) {
            const int hd = col >> 8, item = (ch * 4 + b) * 4 + hd;
            bf16_t* d = (bf16_t*)((unsigned char*)p.out + OFFO_QHAT) + qf_off(item, idx, col & 255);
#pragma unroll
            for (int e = 0; e < 4; ++e) d[e * 8] = f2bf(v[e] * rs[e][0]);
        } else if (col < 2048) {
            const int c = col - 1024, hd = c >> 8, item = (ch * 4 + b) * 4 + hd;
            bf16_t* d = (bf16_t*)(p.ws + OFF_KHAT) + (size_t)row0 * 1024 + c;
#pragma unroll
            for (int e = 0; e < 4; ++e) { v[e] *= rs[e][1]; d[(size_t)e * 1024] = f2bf(v[e]); }
            u32x2 wv; wv[0] = cvt_pk(v[0], v[1]); wv[1] = cvt_pk(v[2], v[3]);
            *(u32x2*)((bf16_t*)(p.ws + OFF_KHATT) + kf_off(item, c & 255, idx)) = wv;
        } else {
            const int c = col - 2048, hd = c >> 9, item = (ch * 4 + b) * 4 + hd;
            u32x2 wv; wv[0] = cvt_pk(v[0], v[1]); wv[1] = cvt_pk(v[2], v[3]);
            *(u32x2*)((bf16_t*)(p.ws + OFF_VT1) + vf_off(item, c & 511, idx)) = wv;
        }
    } else if (EPI == EPI_E5B) {
        const u32x2 ov = *(const u32x2*)((const bf16_t*)(p.ws + OFF_VT1) + vf_off((((pos + 48) >> 6) * 4 + b) * 4 + (col >> 9), col & 511, (pos + 48) & 63));
        bf16_t* d = (bf16_t*)(p.ws + OFF_YB) + (size_t)row0 * 2048 + col;
#pragma unroll
        for (int e = 0; e < 4; ++e) {
            const unsigned ob = (e & 1) ? (ov[e >> 1] & 0xffff0000u) : (ov[e >> 1] << 16);
            const float o = __uint_as_float(ob);
            const float gte = v[e] / (1.f + __expf(-v[e]));
            d[(size_t)e * 2048] = f2bf(gte * o * s_aux[lrow0 + e]);
        }
    }
}

constexpr int G_BK = 64, G_HALF = 128, G_HT = G_HALF * G_BK;
DI int lds_byte(int r, int c) { const int st = (r >> 4) * 2 + (c >> 5), rr = r & 15, cc = c & 31, ob = rr * 64 + cc * 2; return st * 1024 + (ob ^ (((ob >> 9) & 1) << 5)); }
DI void stage_rc(int b, int& R, int& C) { const int st = b / 1024, sb = b % 1024, swz = sb ^ (((sb >> 9) & 1) << 5); R = (st >> 1) * 16 + swz / 64; C = (st & 1) * 32 + (swz % 64) / 2; }

template <int EPI, int K, int LNI>
DI void gemm_tail_unit(const Params& p, const bf16_t* __restrict__ A, const bf16_t* __restrict__ Bt, const int un, float* s_aux) {
    const int tid = opaque_tid(), lane = tid & 63, w = tid >> 6, r = lane & 31, h = lane >> 5;
    constexpr int ROW0 = 32768, KS = K / 8;
    const int col0 = un * 64;
    if (EPI == EPI_E5B) {
        if (tid < 64) {
            const int hd = col0 >> 9;
            const float* pp = (const float*)((unsigned char*)p.out + OFFO_PART) + (size_t)(ROW0 + tid) * 256 + hd * 64;
            float sacc = 0.f;
#pragma unroll
            for (int i = 0; i < 16; ++i) { const f32x4 v = *(const f32x4*)(pp + i * 4); sacc += (v[0] + v[1]) + (v[2] + v[3]); }
            s_aux[tid] = __frsqrt_rn(sacc * (1.0f / 512.0f) + 1e-6f);
        }
    }
    f32x16 acc[2][2];
    acc[0][0] = zero16(); acc[0][1] = zero16(); acc[1][0] = zero16(); acc[1][1] = zero16();
    const bf16_t* ap = A + (size_t)(ROW0 + r) * K + w * KS + h * 8;
    const bf16_t* bp = Bt + (size_t)(col0 + r) * K + w * KS + h * 8;
#pragma unroll 8
    for (int s = 0; s < KS / 16; ++s) {
        const bf16x8 a0 = *(const bf16x8*)(ap + s * 16), a1 = *(const bf16x8*)(ap + (size_t)32 * K + s * 16);
        const bf16x8 b0 = *(const bf16x8*)(bp + s * 16), b1 = *(const bf16x8*)(bp + (size_t)32 * K + s * 16);
        acc[0][0] = mfma32(a0, b0, acc[0][0]); acc[0][1] = mfma32(a0, b1, acc[0][1]);
        acc[1][0] = mfma32(a1, b0, acc[1][0]); acc[1][1] = mfma32(a1, b1, acc[1][1]);
    }
    float* red = (float*)dsm;
#pragma unroll
    for (int i = 0; i < 2; ++i)
#pragma unroll
        for (int j = 0; j < 2; ++j)
#pragma unroll
            for (int reg = 0; reg < 16; ++reg) red[((w * 4 + i * 2 + j) * 16 + reg) * 64 + lane] = acc[i][j][reg];
    __syncthreads();
    {
        const int tile = w >> 1, i = tile >> 1, j = tile & 1;
#pragma unroll
        for (int gg = 0; gg < 2; ++gg) {
            const int g = 2 * (w & 1) + gg;
            float v[4];
#pragma unroll
            for (int e = 0; e < 4; ++e) {
                float sacc = 0.f;
#pragma unroll
                for (int wv = 0; wv < 8; ++wv) sacc += red[((wv * 4 + tile) * 16 + 4 * g + e) * 64 + lane];
                v[e] = sacc;
            }
            const int lrow0 = i * 32 + 8 * g + 4 * h;
            f32x2 rs[4]; float lng = 1.f, lnb = 0.f;
            if (EPI == EPI_E5) {
                lng = log2f(1.f - ex2(-5.f - (float)((col0 >> 8) & 3)));
                const int idx_ = (((ROW0 + lrow0) % LT) + 48) & 63;
#pragma unroll
                for (int e = 0; e < 4; ++e) rs[e] = (f32x2){ex2(lng * (float)(idx_ + e + 1)), 0.0625f * ex2(lng * (float)(63 - idx_ - e))};
            }
            if (EPI == EPI_RESID && LNI >= 0) {
                const f32x2* st_ = (const f32x2*)((unsigned char*)p.out + OFFO_STATS) + ROW0 + lrow0;
#pragma unroll
                for (int e = 0; e < 4; ++e) rs[e] = st_[e];
                lng = p.ln_g[(LNI < 0 ? 0 : LNI) * 1024 + col0 + j * 32 + r]; lnb = p.ln_b[(LNI < 0 ? 0 : LNI) * 1024 + col0 + j * 32 + r];
            }
            epi_store<EPI, LNI>(p, ROW0 + lrow0, col0 + j * 32 + r, lrow0, v, s_aux, rs, lng, lnb);
        }
    }
    __syncthreads();
}

template <int EPI, int K, int LNI = -1>
DI void ph_gemm(const Params& p, const bf16_t* __restrict__ A, const bf16_t* __restrict__ Bt, int N, float* s_aux) {
    constexpr int NXCD = 8, WGM = 8;
    const int nM = 128, nN = N / 256, nwg = nM * nN;
    auto unit = [&](int it, int& pm, int& pn) {
        int wgid = it;
        { const int q = nwg / NXCD, r = nwg % NXCD, xcd = wgid % NXCD, off = wgid / NXCD; wgid = (xcd < r ? xcd * (q + 1) : r * (q + 1) + (xcd - r) * q) + off; }
        const int nig = WGM * nN, gid = wgid / nig, fm = gid * WGM, gsz = min(nM - fm, WGM);
        pm = fm + ((wgid % nig) % gsz); pn = (wgid % nig) / gsz;
    };
    bf16_t* shm = (bf16_t*)dsm;
    typedef __attribute__((address_space(3))) unsigned lds_u32;
    typedef __attribute__((address_space(3))) unsigned char lds_u8;
#define SA(b, h) (shm + ((b) * 2 + (h)) * G_HT)
#define SB(b, h) (shm + (4 + (b) * 2 + (h)) * G_HT)
#define STAGE(P, g) do { const char* g_ = (const char*)(g); \
        __builtin_amdgcn_global_load_lds((const unsigned*)(g_ + so0), (lds_u32*)((lds_u8*)(P) + sb0), 16, 0, 0); \
        __builtin_amdgcn_global_load_lds((const unsigned*)(g_ + so1), (lds_u32*)((lds_u8*)(P) + sb0 + 8192), 16, 0, 0); } while (0)
#define LDA(dst, b, h) for (int m = 0; m < 4; ++m) for (int k = 0; k < 2; ++k) \
        dst[m][k] = *reinterpret_cast<const bf16x8*>((char*)SA(b, h) + lds_byte(wr * 64 + m * 16 + fr, k * 32 + fq * 8))
#define LDB(dst, b, h) for (int n = 0; n < 2; ++n) for (int k = 0; k < 2; ++k) \
        dst[n][k] = *reinterpret_cast<const bf16x8*>((char*)SB(b, h) + lds_byte(wc * 32 + n * 16 + fr, k * 32 + fq * 8))
#define MMA(ai, bj, At_, Bt_) do { __builtin_amdgcn_s_setprio(1); \
        for (int m = 0; m < 4; ++m) for (int n = 0; n < 2; ++n) for (int k = 0; k < 2; ++k) \
            acc[ai][bj][m][n] = __builtin_amdgcn_mfma_f32_16x16x32_bf16(At_[m][k], Bt_[n][k], acc[ai][bj][m][n], 0, 0, 0); \
        __builtin_amdgcn_s_setprio(0); } while (0)
#define WAIT_V(n) asm volatile("s_waitcnt vmcnt(" #n ")" ::: "memory")
#define WAIT_L(n) asm volatile("s_waitcnt lgkmcnt(" #n ")" ::: "memory")
#define BAR __builtin_amdgcn_s_barrier()
#define SCHED __builtin_amdgcn_sched_barrier(0)
    const int wid = opaque_tid() >> 6, lane = opaque_tid() & 63, wr = wid >> 2, wc = wid & 3, fr = lane & 15, fq = lane >> 4;
    const int sb0 = opaque_tid() * 16;
    unsigned so0, so1;
    { int r_, c_; stage_rc(sb0, r_, c_); so0 = (unsigned)(r_ * K + c_) * 2u; stage_rc(sb0 + 8192, r_, c_); so1 = (unsigned)(r_ * K + c_) * 2u; }
    constexpr int nt = K / G_BK;
    constexpr size_t hstep = (size_t)G_HALF * K, kstep = G_BK;

    int it = blockIdx.x, pm, pn;
    unit(it, pm, pn);
    const bf16_t* cA = A + (size_t)pm * 256 * K; const bf16_t* cB = Bt + (size_t)pn * 256 * K;
    STAGE(SB(0, 0), cB); STAGE(SB(0, 1), cB + hstep); STAGE(SA(0, 0), cA); STAGE(SA(0, 1), cA + hstep);
    if (wr == 1) BAR;
    WAIT_V(2); BAR;
    STAGE(SB(1, 0), cB + kstep); STAGE(SA(1, 0), cA + kstep); STAGE(SB(1, 1), cB + hstep + kstep);
    WAIT_V(6); BAR;
    f32x4 acc[2][2][4][2] = {};
    bf16x8 At[4][2], B0[2][2], B1[2][2];
    int cnt = 0;
    for (;;) {
        const int itn = it + (int)gridDim.x;
        const bool has_next = itn < nwg;
        int npm = pm, npn = pn;
        if (has_next) unit(itn, npm, npn);
        const bf16_t* nA = A + (size_t)npm * 256 * K; const bf16_t* nB = Bt + (size_t)npn * 256 * K;
        const int brow = pm * 256, bcol = pn * 256;
        float* sa = s_aux + (cnt & 1) * 512;
        if (EPI == EPI_E5B) {
            if (opaque_tid() < 256) {
                const int row = brow + (int)opaque_tid(); const int hd = bcol >> 9;
                const float* pp = (const float*)((unsigned char*)p.out + OFFO_PART) + (size_t)row * 256 + hd * 64;
                float sacc = 0.f;
#pragma unroll
                for (int i = 0; i < 16; ++i) { const f32x4 v = *(const f32x4*)(pp + i * 4); sacc += (v[0] + v[1]) + (v[2] + v[3]); }
                sa[opaque_tid()] = __frsqrt_rn(sacc * (1.0f / 512.0f) + 1e-6f);
            }
        }
        for (int t = 0; t < nt; t += 2) {
            const bool last = (t == nt - 2);
            const bf16_t* a1 = cA + (size_t)(t + 1) * kstep;
            const bf16_t* a2 = last ? nA : cA + (size_t)(t + 2) * kstep; const bf16_t* b2 = last ? nB : cB + (size_t)(t + 2) * kstep;
            const bf16_t* a3 = a2 + kstep; const bf16_t* b3 = b2 + kstep;
            LDB(B0, 0, 0); LDB(B1, 0, 1); SCHED; LDA(At, 0, 0); STAGE(SA(1, 1), a1 + hstep);
            WAIT_V(8); WAIT_L(0); BAR; MMA(0, 0, At, B0); MMA(0, 1, At, B1); BAR; SCHED;
            LDA(At, 0, 1); STAGE(SB(0, 0), b2); STAGE(SB(0, 1), b2 + hstep); STAGE(SA(0, 0), a2);
            WAIT_V(8); WAIT_L(0); BAR; MMA(1, 0, At, B0); MMA(1, 1, At, B1); BAR; SCHED;
            LDB(B0, 1, 0); LDB(B1, 1, 1); SCHED; LDA(At, 1, 0); STAGE(SA(0, 1), a2 + hstep);
            WAIT_V(8); WAIT_L(0); BAR; MMA(0, 0, At, B0); MMA(0, 1, At, B1); BAR; SCHED;
            LDA(At, 1, 1); STAGE(SB(1, 0), b3); STAGE(SB(1, 1), b3 + hstep); STAGE(SA(1, 0), a3);
            WAIT_V(8); WAIT_L(0); BAR; MMA(1, 0, At, B0); MMA(1, 1, At, B1); BAR; SCHED;
        }
        if (wr == 0) BAR;
        {
            int oz = 0; asm volatile("" : "+v"(oz));
            float lg_[2][2], lb_[2][2];
#pragma unroll
            for (int bj = 0; bj < 2; ++bj)
#pragma unroll
                for (int n = 0; n < 2; ++n) {
                    lg_[bj][n] = 1.f; lb_[bj][n] = 0.f;
                    if (EPI == EPI_E5) lg_[bj][n] = log2f(1.f - ex2(-5.f - (float)((bcol >> 8) & 3)));
                    if (EPI == EPI_RESID && LNI >= 0) { const int c_ = bcol + bj * 128 + wc * 32 + n * 16 + fr; lg_[bj][n] = p.ln_g[(LNI < 0 ? 0 : LNI) * 1024 + c_]; lb_[bj][n] = p.ln_b[(LNI < 0 ? 0 : LNI) * 1024 + c_]; }
                }
#pragma unroll
            for (int ai = 0; ai < 2; ++ai)
#pragma unroll
                for (int m = 0; m < 4; ++m) {
                    const int lrow0 = ai * 128 + wr * 64 + m * 16 + fq * 4, row0 = brow + lrow0 + oz;
                    f32x2 rs[4];
                    if (EPI == EPI_RESID && LNI >= 0) {
                        const f32x2* st_ = (const f32x2*)((unsigned char*)p.out + OFFO_STATS) + row0;
#pragma unroll
                        for (int e = 0; e < 4; ++e) rs[e] = st_[e];
                    }
                    if (EPI == EPI_E5) {
                        const int idx_ = ((row0 % LT) + 48) & 63; const float lgh = lg_[0][0];
#pragma unroll
                        for (int e = 0; e < 4; ++e) rs[e] = (f32x2){ex2(lgh * (float)(idx_ + e + 1)), 0.0625f * ex2(lgh * (float)(63 - idx_ - e))};
                    }
#pragma unroll
                    for (int bj = 0; bj < 2; ++bj)
#pragma unroll
                        for (int n = 0; n < 2; ++n) {
                            float v[4];
#pragma unroll
                            for (int e = 0; e < 4; ++e) v[e] = acc[ai][bj][m][n][e];
                            epi_store<EPI, LNI>(p, row0, bcol + bj * 128 + wc * 32 + n * 16 + fr + oz, lrow0, v, sa, rs, lg_[bj][n], lb_[bj][n]);
                        }
                }
        }
        if (!has_next) break;
#pragma unroll
        for (int a = 0; a < 2; ++a)
#pragma unroll
            for (int b = 0; b < 2; ++b)
#pragma unroll
                for (int m = 0; m < 4; ++m)
#pragma unroll
                    for (int n = 0; n < 2; ++n) acc[a][b][m][n] = (f32x4){0.f, 0.f, 0.f, 0.f};
        pm = npm; pn = npn; cA = nA; cB = nB; it = itn; ++cnt;
        if (wr == 1) BAR;
    }
    WAIT_V(0);
    BAR;
#undef SA
#undef SB
#undef STAGE
#undef LDA
#undef LDB
#undef MMA
    __syncthreads();
    for (int un = blockIdx.x; un < N / 64; un += gridDim.x) gemm_tail_unit<EPI, K, LNI>(p, A, Bt, un, s_aux);
}

DI void ph_fb(const Params& p) {
    const int lane = opaque_tid() & 63;
    const int gw = blockIdx.x * 8 + (opaque_tid() >> 6), nw = gridDim.x * 8;
    float* H = (float*)(p.ws + OFF_H); bf16_t* HB = (bf16_t*)(p.ws + OFF_HB);
    float* LF = (float*)(p.ws + OFF_LOGF);
    f32x4 w0[4][4], w1[4][4];
#pragma unroll
    for (int i = 0; i < 4; ++i)
#pragma unroll
        for (int e = 0; e < 4; ++e) {
            const float* wp = p.ew_in + (size_t)(256 * i + 4 * lane + e) * 3080 + 3072;
            w0[i][e] = *(const f32x4*)wp; w1[i][e] = *(const f32x4*)(wp + 4);
        }
    const int j8 = ((lane >> 5) & 1) * 4 + ((lane >> 4) & 1) * 2 + ((lane >> 3) & 1);
    const float fbias = p.ef_bias[j8];
    for (int m = gw; m < MT; m += nw) {
        const int b_ = m / LT, pos_ = m - b_ * LT;
        const float* hrow = pos_ < 16 ? p.meta + (size_t)pos_ * 1024 : p.x + ((size_t)b_ * 8192 + (pos_ - 16)) * 1024;
        f32x4 hv[4];
#pragma unroll
        for (int i = 0; i < 4; ++i) hv[i] = *(const f32x4*)(hrow + 256 * i + 4 * lane);
#pragma unroll
        for (int i = 0; i < 4; ++i) {
            *(f32x4*)(H + (size_t)m * 1024 + 256 * i + 4 * lane) = hv[i];
            u32x2 wv; wv[0] = cvt_pk(hv[i][0], hv[i][1]); wv[1] = cvt_pk(hv[i][2], hv[i][3]);
            *(u32x2*)(HB + (size_t)m * 1024 + 256 * i + 4 * lane) = wv;
        }
        float a[8];
#pragma unroll
        for (int j = 0; j < 8; ++j) a[j] = 0.f;
#pragma unroll
        for (int i = 0; i < 4; ++i)
#pragma unroll
            for (int e = 0; e < 4; ++e) {
                const float x = hv[i][e];
                a[0] += x * w0[i][e][0]; a[1] += x * w0[i][e][1]; a[2] += x * w0[i][e][2]; a[3] += x * w0[i][e][3];
                a[4] += x * w1[i][e][0]; a[5] += x * w1[i][e][1]; a[6] += x * w1[i][e][2]; a[7] += x * w1[i][e][3];
            }
        const bool b5 = (lane & 32) != 0, b4 = (lane & 16) != 0, b3 = (lane & 8) != 0;
        float c4[4];
#pragma unroll
        for (int j = 0; j < 4; ++j) { const float send = b5 ? a[j] : a[j + 4]; const float keep = b5 ? a[j + 4] : a[j]; c4[j] = keep + __shfl_xor(send, 32); }
        float c2[2];
#pragma unroll
        for (int j = 0; j < 2; ++j) { const float send = b4 ? c4[j] : c4[j + 2]; const float keep = b4 ? c4[j + 2] : c4[j]; c2[j] = keep + __shfl_xor(send, 16); }
        float v;
        { const float send = b3 ? c2[0] : c2[1]; const float keep = b3 ? c2[1] : c2[0]; v = keep + __shfl_xor(send, 8); }
        v += __shfl_xor(v, 4); v += __shfl_xor(v, 2); v += __shfl_xor(v, 1);
        if ((lane & 7) == 0) {
            const float xx = v + fbias;
            const float ls = fminf(xx, 0.f) - log1pf(expf(-fabsf(xx)));
            const int b = m / LT, pos = m - b * LT;
            LF[(size_t)(b * 8 + j8) * LP + pos] = ls;
        }
    }
}

DI void ph_cumsum(const Params& p, bf16_t* smem) {
    float* sm = (float*)smem;
    const int tid = opaque_tid(), lane = tid & 63, w = tid >> 6;
    const float* LF = (const float*)(p.ws + OFF_LOGF);
    float* CF = (float*)(p.ws + OFF_CUMF);
    for (int it = blockIdx.x; it < 32; it += gridDim.x) {
        const float* src = LF + (size_t)it * LP; float* dst = CF + (size_t)it * LP;
        const int p0 = tid * 17;
        float v[17];
#pragma unroll
        for (int i = 0; i < 17; ++i) { const int pos = p0 + i; v[i] = (pos < LT) ? src[pos] : 0.f; }
        float s = 0.f;
#pragma unroll
        for (int i = 0; i < 17; ++i) s += v[i];
        float incl = s;
#pragma unroll
        for (int o = 1; o < 64; o <<= 1) { const float t = __shfl_up(incl, o); if (lane >= o) incl += t; }
        __syncthreads();
        if (lane == 63) sm[w] = incl;
        __syncthreads();
        float run = incl - s;
        for (int w2 = 0; w2 < w; ++w2) run += sm[w2];
#pragma unroll
        for (int i = 0; i < 17; ++i) { const int pos = p0 + i; run += v[i]; if (pos < LP) dst[pos] = run * LOG2E; }
    }
}

template <int DV, bool FOX>
DI void flash(f32x16 (&O)[DV / 32], const bf16_t* __restrict__ qptr, const bf16_t* __restrict__ kg, const bf16_t* __restrict__ vtg,
              int ntiles, int q, float slope2, const float* __restrict__ cum2, float KN, bf16_t* smem) {
    constexpr int NDT = DV / 32;
    constexpr int KS_ELEMS = 64 * 72, VS_ELEMS = DV * 72, BUF = KS_ELEMS + VS_ELEMS;
    const int tid = opaque_tid(), lane = tid & 63, r = lane & 31, h = lane >> 5;
    const int w = tid >> 6;
    const int pr = perm23(r);
    const int cc = tid & 7, r0 = tid >> 3;
    int* flags = (int*)(dsm + SMEM_BYTES - 256);
    bf16x8 qf[4];
#pragma unroll
    for (int ks = 0; ks < 4; ++ks) qf[ks] = *(const bf16x8*)(qptr + ks * 16 + h * 8);
    float qn2 = 0.f;
#pragma unroll
    for (int ks = 0; ks < 4; ++ks)
#pragma unroll
        for (int j = 0; j < 8; ++j) { const float x = __uint_as_float(((unsigned)(unsigned short)qf[ks][j]) << 16); qn2 += x * x; }
    qn2 = xsum32(qn2);
    const float c1 = 0.125f * LOG2E;
    const float sbound = sqrtf(qn2) * KN * c1 * 1.001f + 0.01f;
    float m = -1e30f, l = 0.f;
#pragma unroll
    for (int dt = 0; dt < NDT; ++dt) O[dt] = zero16();
    const float cq = FOX ? cum2[min(q, LT - 1)] : 0.f;
    const int kend = FOX ? q + 1 : 16 + 64 * ((q + 48) >> 6);
    const int wkend = __builtin_amdgcn_readfirstlane(FOX ? (q | 31) + 1 : 16 + 64 * (((q | 31) + 48) >> 6));
    const int qlo = __builtin_amdgcn_readfirstlane(q & ~31);

    constexpr int NVR = DV / 64;
    u32x4 kr[2], vr[2][NVR];
#define LOAD_PAIR(ktA) do { _Pragma("unroll") for (int j_ = 0; j_ < 2; ++j_) { const int kt_ = (ktA) - j_; if (kt_ >= 0) { const int kb_ = kt_ * 64; \
        { const int krow = min(kb_ + r0, LT - 1); kr[j_] = *(const u32x4*)(kg + (size_t)krow * 2048 + cc * 8); } \
        _Pragma("unroll") for (int i = 0; i < NVR; ++i) vr[j_][i] = *(const u32x4*)(vtg + ((size_t)kt_ * 4096 + r0 + 64 * i) * 64 + cc * 8); } } } while (0)
#define STORE_PAIR(stage) do { _Pragma("unroll") for (int j_ = 0; j_ < 2; ++j_) { bf16_t* Kd = smem + ((stage) * 2 + j_) * BUF; bf16_t* Vd = Kd + KS_ELEMS; \
        *(u32x4*)(Kd + r0 * 72 + cc * 8) = kr[j_]; \
        _Pragma("unroll") for (int i = 0; i < NVR; ++i) *(u32x4*)(Vd + (r0 + 64 * i) * 72 + cc * 8) = vr[j_][i]; } } while (0)
    kr[0] = kr[1] = (u32x4){0u, 0u, 0u, 0u};
#pragma unroll
    for (int i = 0; i < NVR; ++i) vr[0][i] = vr[1][i] = (u32x4){0u, 0u, 0u, 0u};
    LOAD_PAIR(ntiles - 1);
    STORE_PAIR(0);
    __syncthreads();
    bool wskip = false;
    const int npairs = (ntiles + 1) >> 1;
    for (int pit = 0; pit < npairs; ++pit) {
        const int kt0 = ntiles - 1 - 2 * pit;
        const int cur = pit & 1;
        const bool more = pit + 1 < npairs;
        if (more) LOAD_PAIR(kt0 - 2);
        float ckl0 = 0.f, ckl1 = 0.f;
        if (FOX) { if (kt0 > 0) ckl0 = cum2[kt0 * 64 - 1]; if (kt0 > 1) ckl1 = cum2[(kt0 - 1) * 64 - 1]; }
#pragma unroll 1
        for (int pj = 0; pj < 2; ++pj) {
        const int kt = kt0 - pj;
        if (kt < 0) break;
        const bf16_t* Ks = smem + (cur * 2 + pj) * BUF; const bf16_t* Vs = Ks + KS_ELEMS;
        const int kb = kt * 64;
        const float cklast = pj ? ckl1 : ckl0;
        if (kb < wkend && !wskip && qlo < LT) {
        f32x16 s[2];
#pragma unroll
        for (int sub = 0; sub < 2; ++sub) {
            s[sub] = zero16();
#pragma unroll
            for (int ks = 0; ks < 4; ++ks) {
                const bf16x8 a = *(const bf16x8*)(Ks + (sub * 32 + pr) * 72 + ks * 16 + h * 8);
                s[sub] = mfma32(a, qf[ks], s[sub]);
            }
        }
        float mx = -INFINITY;
        if (kb + 63 < qlo) {
#pragma unroll
            for (int sub = 0; sub < 2; ++sub) {
#pragma unroll
                for (int i8 = 0; i8 < 2; ++i8) {
                    const int k0 = kb + sub * 32 + 16 * i8 + 8 * h;
                    float ck[8];
                    float base = 0.f;
                    if (FOX) {
                        const f32x4 c0 = *(const f32x4*)(cum2 + k0), c1v = *(const f32x4*)(cum2 + k0 + 4);
                        ck[0] = c0[0]; ck[1] = c0[1]; ck[2] = c0[2]; ck[3] = c0[3]; ck[4] = c1v[0]; ck[5] = c1v[1]; ck[6] = c1v[2]; ck[7] = c1v[3];
                    } else base = -slope2 * (float)(q - k0);
#pragma unroll
                    for (int e = 0; e < 8; ++e) {
                        const float bias = FOX ? cq - ck[e] : fmaf(slope2, (float)e, base);
                        const float t = fmaf(s[sub][8 * i8 + e], c1, bias);
                        s[sub][8 * i8 + e] = t;
                        mx = fmaxf(mx, t);
                    }
                }
            }
        } else {
#pragma unroll
            for (int sub = 0; sub < 2; ++sub) {
#pragma unroll
                for (int i8 = 0; i8 < 2; ++i8) {
                    const int k0 = kb + sub * 32 + 16 * i8 + 8 * h;
                    float ck[8];
                    if (FOX) {
                        const f32x4 c0 = *(const f32x4*)(cum2 + k0), c1v = *(const f32x4*)(cum2 + k0 + 4);
                        ck[0] = c0[0]; ck[1] = c0[1]; ck[2] = c0[2]; ck[3] = c0[3]; ck[4] = c1v[0]; ck[5] = c1v[1]; ck[6] = c1v[2]; ck[7] = c1v[3];
                    }
#pragma unroll
                    for (int e = 0; e < 8; ++e) {
                        const int k = k0 + e;
                        float t = s[sub][8 * i8 + e] * c1;
                        if (FOX) t += cq - ck[e];
                        else t -= slope2 * fabsf((float)(q - k));
                        t = (k < kend) ? t : -INFINITY;
                        s[sub][8 * i8 + e] = t;
                        mx = fmaxf(mx, t);
                    }
                }
            }
        }
        mx = xmax32(mx);
        const float mn = fmaxf(m, mx);
        if (__any(mn > m)) {
            const float alpha = ex2(m - mn);
            l *= alpha;
#pragma unroll
            for (int dt = 0; dt < NDT; ++dt)
#pragma unroll
                for (int i = 0; i < 16; ++i) O[dt][i] *= alpha;
        }
        m = mn;
#pragma unroll
        for (int sub = 0; sub < 2; ++sub)
#pragma unroll
            for (int i = 0; i < 16; ++i) { const float pv = ex2(s[sub][i] - mn); s[sub][i] = pv; l += pv; }
        bf16x8 pf[2][2];
        pf[0][0] = pack8<0>(s[0]); pf[0][1] = pack8<1>(s[0]); pf[1][0] = pack8<0>(s[1]); pf[1][1] = pack8<1>(s[1]);
#pragma unroll
        for (int dt = 0; dt < NDT; ++dt)
#pragma unroll
            for (int sub = 0; sub < 2; ++sub)
#pragma unroll
                for (int s2 = 0; s2 < 2; ++s2) {
                    const bf16x8 a = *(const bf16x8*)(Vs + (dt * 32 + r) * 72 + sub * 32 + 16 * s2 + 8 * h);
                    O[dt] = mfma32(a, pf[sub][s2], O[dt]);
                }
        }
        if (kt > 0) {
            const int klast = kb - 1;
            float bm = 0.f;
            if (klast < q) bm = FOX ? cq - cklast : -slope2 * (float)(q - klast);
            const bool pred = (q >= LT) || (sbound + bm < m - 152.f);
            wskip = __all(pred);
        }
        }
        if (more) {
            if (lane == 0) flags[cur * 8 + w] = wskip ? 1 : 0;
            STORE_PAIR(cur ^ 1);
        }
        __syncthreads();
        if (more) {
            const int4 f0 = *(const int4*)(flags + cur * 8), f1 = *(const int4*)(flags + cur * 8 + 4);
            if ((f0.x & f0.y & f0.z & f0.w & f1.x & f1.y & f1.z & f1.w) != 0) break;
        }
    }
#undef LOAD_PAIR
#undef STORE_PAIR
    l = xsum32(l);
    const float inv = 1.0f / l;
#pragma unroll
    for (int dt = 0; dt < NDT; ++dt)
#pragma unroll
        for (int i = 0; i < 16; ++i) O[dt][i] *= inv;
}

DI void ph_knorm(const Params& p) {
    const int tid = opaque_tid(), lane = tid & 63;
    const int gw = blockIdx.x * 8 + (tid >> 6), nw = gridDim.x * 8;
    const bf16_t* PQK = (const bf16_t*)(p.ws + OFF_PQK);
    unsigned* knm = (unsigned*)(p.ws + OFF_CNT) + 128;
    for (int u = gw; u < BATCH * 513; u += nw) {
        const int b = u / 513, ch = u - b * 513;
        float mxa = 0.f, mxb = 0.f;
        const bf16_t* base = PQK + ((size_t)b * LT + ch * 16) * 2048 + lane * 8;
#pragma unroll
        for (int i = 0; i < 16; ++i) {
            const u32x4 va = *(const u32x4*)(base + (size_t)i * 2048 + 512), vb = *(const u32x4*)(base + (size_t)i * 2048 + 1536);
            float sa = 0.f, sb = 0.f;
#pragma unroll
            for (int e = 0; e < 4; ++e) {
                const float a0 = __uint_as_float(va[e] << 16), a1 = __uint_as_float(va[e] & 0xffff0000u);
                const float b0 = __uint_as_float(vb[e] << 16), b1 = __uint_as_float(vb[e] & 0xffff0000u);
                sa += a0 * a0 + a1 * a1; sb += b0 * b0 + b1 * b1;
            }
            sa += __shfl_xor(sa, 1); sa += __shfl_xor(sa, 2); sa += __shfl_xor(sa, 4);
            sb += __shfl_xor(sb, 1); sb += __shfl_xor(sb, 2); sb += __shfl_xor(sb, 4);
            mxa = fmaxf(mxa, sa); mxb = fmaxf(mxb, sb);
        }
        if ((lane & 7) == 0) {
            atomicMax(knm + b * 16 + (lane >> 3), __float_as_uint(mxa));
            atomicMax(knm + b * 16 + 8 + (lane >> 3), __float_as_uint(mxb));
        }
    }
}

DI void ph_attn(const Params& p, bf16_t* smem, int* s_item) {
    const int tid = opaque_tid(), lane = tid & 63, w = tid >> 6, r = lane & 31, h = lane >> 5;
    const bf16_t* PQK = (const bf16_t*)(p.ws + OFF_PQK);
    bf16_t* MIX = (bf16_t*)(p.ws + OFF_HB);
    const float lam = ((const float*)(p.ws + OFF_MISC))[0];
    unsigned* ctr = (unsigned*)(p.ws + OFF_CNT);
    const unsigned* knm = (const unsigned*)(p.ws + OFF_CNT) + 128;
    constexpr int NQB = 33, NDIFF = NQB * 16, NITEM = NQB * 48;
    for (;;) {
        __syncthreads();
        if (tid == 0) *s_item = (int)atomicAdd(ctr, 1u);
        __syncthreads();
        const int it = *s_item;
        if (it >= NITEM) break;
        const int cls = it / 132, jj = it - cls * 132;
        const int code = (int)((0xBA7654932108ull >> (4 * (11 - cls))) & 15ull);
        const int qbi = NQB - 1 - (jj >> 2), bi = jj & 3;
        if (code & 8) {
            const int qb = qbi;
            const int q = qb * 256 + w * 32 + r;
            const int b = bi, hd = code & 7;
            const int ntiles = (min(LT, qb * 256 + 272) + 63) >> 6;
            const size_t qrow = (size_t)b * LT + min(q, LT - 1);
            const float slope2 = ex2(-2.f * (float)(hd + 1)) * LOG2E;
            const bf16_t* vt = (const bf16_t*)(p.ws + OFF_VTA) + (size_t)(b * 512 + hd * 128) * 64;
            f32x16 O0[4];
            float* scr = p.out + (size_t)blockIdx.x * 32768 + tid * 64;
            flash<128, false>(O0, PQK + qrow * 2048 + hd * 128, PQK + (size_t)b * LT * 2048 + 512 + hd * 128, vt, ntiles, q, slope2, nullptr, sqrtf(__uint_as_float(knm[b * 16 + hd * 2])), smem);
#pragma unroll
            for (int dt = 0; dt < 4; ++dt)
#pragma unroll
                for (int g = 0; g < 4; ++g) *(f32x4*)(scr + dt * 16 + 4 * g) = (f32x4){O0[dt][4 * g], O0[dt][4 * g + 1], O0[dt][4 * g + 2], O0[dt][4 * g + 3]};
            flash<128, false>(O0, PQK + qrow * 2048 + hd * 128 + 64, PQK + (size_t)b * LT * 2048 + 512 + hd * 128 + 64, vt, ntiles, q, slope2, nullptr, sqrtf(__uint_as_float(knm[b * 16 + hd * 2 + 1])), smem);
            float ss = 0.f;
#pragma unroll
            for (int dt = 0; dt < 4; ++dt)
#pragma unroll
                for (int g = 0; g < 4; ++g) {
                    const f32x4 pv = *(const f32x4*)(scr + dt * 16 + 4 * g);
#pragma unroll
                    for (int e = 0; e < 4; ++e) { const float o = pv[e] - lam * O0[dt][4 * g + e]; O0[dt][4 * g + e] = o; ss += o * o; }
                }
            ss = xsum32(ss);
            const float rn = __frsqrt_rn(ss * (1.0f / 128.0f) + 1e-6f) * 0.8f;
            if (q < LT) {
                bf16_t* d = MIX + qrow * 1024 + hd * 128;
#pragma unroll
                for (int dt = 0; dt < 4; ++dt)
#pragma unroll
                    for (int g = 0; g < 4; ++g) {
                        const int dv = dt * 32 + 8 * g + 4 * h;
                        const f32x4 gg = *(const f32x4*)(p.subln + dv);
                        u32x2 wv; wv[0] = cvt_pk(O0[dt][4 * g] * rn * gg[0], O0[dt][4 * g + 1] * rn * gg[1]);
                        wv[1] = cvt_pk(O0[dt][4 * g + 2] * rn * gg[2], O0[dt][4 * g + 3] * rn * gg[3]);
                        *(u32x2*)(d + dv) = wv;
                    }
            }
        } else {
            const int qb = qbi;
            const int q = qb * 256 + w * 32 + r;
            const int b = bi, hf = code & 7;
            const int ntiles = (min(LT, qb * 256 + 256) + 63) >> 6;
            const size_t qrow = (size_t)b * LT + min(q, LT - 1);
            const bf16_t* vt = (const bf16_t*)(p.ws + OFF_VTA) + (size_t)(2048 + b * 512 + hf * 64) * 64;
            f32x16 O[2];
            flash<64, true>(O, PQK + qrow * 2048 + 1024 + hf * 64, PQK + (size_t)b * LT * 2048 + 1536 + hf * 64, vt, ntiles, q, 0.f,
                            (const float*)(p.ws + OFF_CUMF) + (size_t)(b * 8 + hf) * LP, sqrtf(__uint_as_float(knm[b * 16 + 8 + hf])), smem);
            if (q < LT) {
                bf16_t* d = MIX + qrow * 1024 + 512 + hf * 64;
#pragma unroll
                for (int dt = 0; dt < 2; ++dt)
#pragma unroll
                    for (int g = 0; g < 4; ++g) {
                        const int dv = dt * 32 + 8 * g + 4 * h;
                        u32x2 wv; wv[0] = cvt_pk(O[dt][4 * g], O[dt][4 * g + 1]); wv[1] = cvt_pk(O[dt][4 * g + 2], O[dt][4 * g + 3]);
                        *(u32x2*)(d + dv) = wv;
                    }
            }
        }
    }
}

DI void ph_ln(const Params& p, int lnidx, bool last) {
    const int lane = opaque_tid() & 63;
    const int gw = blockIdx.x * 8 + (opaque_tid() >> 6), nw = gridDim.x * 8;
    float* H = (float*)(p.ws + OFF_H); bf16_t* HB = (bf16_t*)(p.ws + OFF_HB);
    const float* G = p.ln_g + (size_t)lnidx * 1024; const float* Bv = p.ln_b + (size_t)lnidx * 1024;
    f32x4 g[4], bb[4];
#pragma unroll
    for (int i = 0; i < 4; ++i) { g[i] = *(const f32x4*)(G + i * 256 + lane * 4); bb[i] = *(const f32x4*)(Bv + i * 256 + lane * 4); }
    f32x4 nv[4];
    if (gw < MT) {
#pragma unroll
        for (int i = 0; i < 4; ++i) nv[i] = *(const f32x4*)(H + (size_t)gw * 1024 + i * 256 + lane * 4);
    }
    for (int m = gw; m < MT; m += nw) {
        f32x4 v[4];
#pragma unroll
        for (int i = 0; i < 4; ++i) v[i] = nv[i];
        const int mn = min(m + nw, MT - 1);
#pragma unroll
        for (int i = 0; i < 4; ++i) nv[i] = *(const f32x4*)(H + (size_t)mn * 1024 + i * 256 + lane * 4);
        float s = 0.f;
#pragma unroll
        for (int i = 0; i < 4; ++i) s += (v[i][0] + v[i][1]) + (v[i][2] + v[i][3]);
        for (int o = 32; o > 0; o >>= 1) s += __shfl_xor(s, o);
        const float mu = s * (1.0f / 1024.0f);
        float qv = 0.f;
#pragma unroll
        for (int i = 0; i < 4; ++i)
#pragma unroll
            for (int e = 0; e < 4; ++e) { const float d = v[i][e] - mu; qv += d * d; }
        for (int o = 32; o > 0; o >>= 1) qv += __shfl_xor(qv, o);
        const float rstd = __frsqrt_rn(qv * (1.0f / 1024.0f) + 1e-5f);
        const int b = m / LT, pos = m - b * LT;
#pragma unroll
        for (int i = 0; i < 4; ++i) {
            const int c = i * 256 + lane * 4;
            f32x4 y;
#pragma unroll
            for (int e = 0; e < 4; ++e) y[e] = (v[i][e] - mu) * rstd * g[i][e] + bb[i][e];
            if (last) {
                if (pos >= 16) *(f32x4*)(p.out + ((size_t)b * 8192 + (pos - 16)) * 1024 + c) = y;
            } else {
                u32x2 wv; wv[0] = cvt_pk(y[0], y[1]); wv[1] = cvt_pk(y[2], y[3]);
                *(u32x2*)(HB + (size_t)m * 1024 + c) = wv;
            }
        }
        if (!last && lane == 0) ((f32x2*)((unsigned char*)p.out + OFFO_STATS))[m] = (f32x2){mu, rstd};
    }
}

DI void ph_zero_ret_pads(const Params& p) {
    const int tid = opaque_tid();
    for (int idx = blockIdx.x * NT + tid; idx < (128 + 256) * 3 * 64; idx += gridDim.x * NT) {
        const int ch16 = idx & 63, blk = idx >> 6, s_ = blk % 3, g = blk / 3;
        bf16_t* base = g < 128 ? (bf16_t*)(p.ws + OFF_KHATT) + (size_t)(g * 4 + s_) * 512 : (bf16_t*)(p.ws + OFF_VT1) + (size_t)((g - 128) * 4 + s_) * 512;
        *(u32x4*)(base + ch16 * 8) = (u32x4){0u, 0u, 0u, 0u};
    }
}

DI void ph_sprep(const Params& p) {
    const int tid = opaque_tid(), lane = tid & 63, w = tid >> 6, r = lane & 31, h = lane >> 5;
    const int it_ = (w >> 1) & 1, jt = w & 1;
    const bf16_t* QH = (const bf16_t*)((unsigned char*)p.out + OFFO_QHAT);
    const bf16_t* KH = (const bf16_t*)(p.ws + OFF_KHAT);
    bf16_t* SB = (bf16_t*)((unsigned char*)p.out + OFFO_SBUF);
    for (int item = blockIdx.x * 2 + (w >> 2); item < NCH * 16; item += gridDim.x * 2) {
        const int c = item >> 4, b = (item >> 2) & 3, hd = item & 3;
        const int ppi = c * 64 + it_ * 32 + r, ppj = c * 64 + jt * 32 + r;
        const bool vi = ppi >= 48, vj = ppj >= 48;
        const bf16_t* qp = QH + (size_t)item * 16384 + (size_t)it_ * 512 + lane * 8;
        const bf16_t* kp = KH + ((size_t)b * LT + (vj ? ppj - 48 : 0)) * 1024 + hd * 256 + h * 8;
        f32x16 acc = zero16();
        const bf16x8 z8 = {0, 0, 0, 0, 0, 0, 0, 0};
#pragma unroll 8
        for (int s = 0; s < 16; ++s) {
            bf16x8 a = *(const bf16x8*)(qp + ((s >> 1) * 4 + (s & 1) * 2) * 512), bq = *(const bf16x8*)(kp + s * 16);
            if (!vi) a = z8;
            if (!vj) bq = z8;
            acc = mfma32(a, bq, acc);
        }
        const float lg = log2f(1.f - ex2(-5.f - (float)hd));
        const int j = jt * 32 + r;
#pragma unroll
        for (int reg = 0; reg < 16; ++reg) {
            const int i = it_ * 32 + crow(reg, h);
            const int e = (i >= j) ? -64 : 2 * (j - i) - 64;
            SB[sf_off(item, i, j)] = f2bf(acc[reg] * ex2(lg * (float)e));
        }
    }
}

DI void scan_block(const Params& p, const int u) {
    const int tid = opaque_tid(), lane = tid & 63, r = lane & 31, h = lane >> 5;
    const int w = __builtin_amdgcn_readfirstlane(tid >> 6);
    const int sl = u & 15, hd = (u >> 4) & 3, b = u >> 6;
    const float lg = log2f(1.f - ex2(-5.f - (float)hd));
    const float cdec = ex2(lg * 64.f);
    const int it0 = b * 4 + hd;
    constexpr size_t KSTEP = (size_t)16 * 8 * 4 * 512, VSTEP = (size_t)16 * 16 * 4 * 512, SSTEP = (size_t)16 * 8 * 512;
    const bf16_t* KF = (const bf16_t*)(p.ws + OFF_KHATT) + (size_t)(it0 * 8 + w) * 4 * 512 + lane * 8;
    const bf16_t* VG = (const bf16_t*)(p.ws + OFF_VT1) + (size_t)(it0 * 16 + sl) * 4 * 512 + (w & 3) * 512 + lane * 8;
    bf16_t* OB = (bf16_t*)(p.ws + OFF_VT1) + (size_t)(it0 * 16 + sl) * 4 * 512;
    const bf16_t* QF = (const bf16_t*)((unsigned char*)p.out + OFFO_QHAT) + (size_t)(it0 * 8 + w) * 4 * 512 + lane * 8;
    const bf16_t* SF = (const bf16_t*)((unsigned char*)p.out + OFFO_SBUF) + (size_t)it0 * 8 * 512 + ((w >> 2) * 4 + (w & 3)) * 512 + lane * 8;
    float* PART = (float*)((unsigned char*)p.out + OFFO_PART);
    f32x4* red = (f32x4*)dsm;
    bf16_t* vlds = (bf16_t*)(dsm + SMEM_BYTES + 4096);
    const bf16x8 z8 = {0, 0, 0, 0, 0, 0, 0, 0};
    const bool ok0 = r >= 48 - 0, ok1 = false;
    (void)ok0; (void)ok1;

    f32x16 st = zero16();
    bf16x8 kaA[4], qA[2][2], sA, kaB[4], qB[2][2], sB, kaC[4], qC[2][2], sC;
    bf16x8 vg = z8, vg2 = z8;
#define LOADSET(KA_, Q_, S_, c_) do { const int cc_ = min((c_), NCH - 1); \
        _Pragma("unroll") for (int s_ = 0; s_ < 4; ++s_) KA_[s_] = *(const bf16x8*)(KF + cc_ * KSTEP + s_ * 512); \
        _Pragma("unroll") for (int it_ = 0; it_ < 2; ++it_) { \
            Q_[it_][0] = *(const bf16x8*)(QF + cc_ * KSTEP + (0 * 2 + it_) * 512); Q_[it_][1] = *(const bf16x8*)(QF + cc_ * KSTEP + (1 * 2 + it_) * 512); \
            if (cc_ * 64 + it_ * 32 + r < 48) { Q_[it_][0] = z8; Q_[it_][1] = z8; } } \
        S_ = *(const bf16x8*)(SF + cc_ * SSTEP); } while (0)
#define SCAN_STEP(c_, KA_, Q_, S_, KL_, QL_, SL_) do { const int c = (c_); \
        if (w < 4) { *(bf16x8*)(vlds + (((c + 1) & 1) * 4 + w) * 512 + lane * 8) = vg; vg = vg2; vg2 = *(const bf16x8*)(VG + (size_t)min(c + 3, NCH - 1) * VSTEP); } \
        LOADSET(KL_, QL_, SL_, c + 2); \
        bf16x8 vf[4]; \
        _Pragma("unroll") for (int s_ = 0; s_ < 4; ++s_) vf[s_] = *(const bf16x8*)(vlds + ((c & 1) * 4 + s_) * 512 + lane * 8); \
        const bf16x8 vw = *(const bf16x8*)(vlds + ((c & 1) * 4 + (w & 3)) * 512 + lane * 8); \
        f32x16 o0 = zero16(), o1 = zero16(); \
        if (w < 4) o0 = mfma32(vw, S_, o0); else o1 = mfma32(vw, S_, o1); \
        { const bf16x8 a0 = pack8<0>(st), a1 = pack8<1>(st); \
          o0 = mfma32(a0, Q_[0][0], o0); o1 = mfma32(a0, Q_[1][0], o1); o0 = mfma32(a1, Q_[0][1], o0); o1 = mfma32(a1, Q_[1][1], o1); } \
        _Pragma("unroll") for (int i = 0; i < 16; ++i) st[i] *= cdec; \
        _Pragma("unroll") for (int s_ = 0; s_ < 4; ++s_) st = mfma32(KA_[s_], vf[s_], st); \
        f32x4* rb = red + (size_t)(((c & 1) * 8 + w) * 8) * 64 + lane; \
        _Pragma("unroll") for (int g = 0; g < 4; ++g) { \
            rb[(0 * 4 + g) * 64] = (f32x4){o0[4 * g], o0[4 * g + 1], o0[4 * g + 2], o0[4 * g + 3]}; \
            rb[(1 * 4 + g) * 64] = (f32x4){o1[4 * g], o1[4 * g + 1], o1[4 * g + 2], o1[4 * g + 3]}; } \
        __syncthreads(); \
        { const int it2 = w >> 2, g2 = w & 3; \
          const f32x4* rr = red + (size_t)((c & 1) * 8 * 8 + it2 * 4 + g2) * 64 + lane; \
          f32x4 a = rr[0]; \
          _Pragma("unroll") for (int wv = 1; wv < 8; ++wv) { const f32x4 t = rr[(size_t)wv * 8 * 64]; a[0] += t[0]; a[1] += t[1]; a[2] += t[2]; a[3] += t[3]; } \
          const int pp = c * 64 + it2 * 32 + r; \
          float ss = (a[0] * a[0] + a[1] * a[1]) + (a[2] * a[2] + a[3] * a[3]); \
          ss = xsum32(ss); \
          const int i_ = it2 * 32 + r; \
          bf16_t* od = OB + c * VSTEP + (size_t)((i_ >> 4) * 64 + ((i_ >> 3) & 1) * 32 + 8 * g2 + 4 * h) * 8 + (i_ & 7); \
          od[0] = f2bf(a[0]); od[8] = f2bf(a[1]); od[16] = f2bf(a[2]); od[24] = f2bf(a[3]); \
          if (h == 0 && pp >= 48) PART[((size_t)b * LT + pp - 48) * 256 + hd * 64 + sl * 4 + g2] = ss; } } while (0)

    if (w < 4) { const bf16x8 v0 = *(const bf16x8*)(VG); *(bf16x8*)(vlds + w * 512 + lane * 8) = v0; vg = *(const bf16x8*)(VG + VSTEP); vg2 = *(const bf16x8*)(VG + 2 * VSTEP); }
    LOADSET(kaA, qA, sA, 0);
    LOADSET(kaB, qB, sB, 1);
    __syncthreads();
    for (int c3 = 0; c3 < NCH; c3 += 3) {
        SCAN_STEP(c3, kaA, qA, sA, kaC, qC, sC);
        SCAN_STEP(c3 + 1, kaB, qB, sB, kaA, qA, sA);
        SCAN_STEP(c3 + 2, kaC, qC, sC, kaB, qB, sB);
    }
#undef LOADSET
#undef SCAN_STEP
    __syncthreads();
}

DI void ph_scan(const Params& p) {
    for (int ub = blockIdx.x; ub < 256; ub += gridDim.x) {
        const int xcd = ub & 7, j = ub >> 3;
        scan_block(p, ((xcd * 2 + (j >> 4)) << 4) | (j & 15));
    }
}

constexpr int NPHASE = 18;
template <int ph>
DI void run_phase(const Params& p, bf16_t* smem, float* s_aux) {
    const bf16_t* HB = (const bf16_t*)(p.ws + OFF_HB);
    switch (ph) {
        case 0: ph_prologue(p, smem); ph_fb(p); break;
        case 1: ph_gemm<EPI_E1, 1024>(p, HB, (const bf16_t*)(p.ws + OFF_W0IN), 3072, s_aux); break;
        case 2: ph_cumsum(p, smem); ph_knorm(p); break;
        case 3: ph_attn(p, smem, (int*)(s_aux + 256)); break;
        case 4: ph_gemm<EPI_RESID, 1024>(p, HB, (const bf16_t*)(p.ws + OFF_W0OUT), 1024, s_aux); break;
        case 5: ph_ln(p, 0, false); break;
        case 6: ph_gemm<EPI_FFN1, 1024>(p, HB, (const bf16_t*)(p.ws + OFF_F1), 4096, s_aux); break;
        case 7: ph_gemm<EPI_RESID, 4096, 0>(p, (const bf16_t*)(p.ws + OFF_U), (const bf16_t*)(p.ws + OFF_F2), 1024, s_aux); break;
        case 8: ph_ln(p, 1, false); break;
        case 9: ph_zero_ret_pads(p); ph_gemm<EPI_E5, 1024>(p, HB, (const bf16_t*)(p.ws + OFF_W1IN), 4096, s_aux); break;
        case 10: ph_sprep(p); break;
        case 11: ph_scan(p); break;
        case 12: ph_gemm<EPI_E5B, 1024>(p, HB, (const bf16_t*)(p.ws + OFF_W1IN) + (size_t)4096 * 1024, 2048, s_aux); break;
        case 13: ph_gemm<EPI_RESID, 2048, 1>(p, (const bf16_t*)(p.ws + OFF_YB), (const bf16_t*)(p.ws + OFF_W1OUT), 1024, s_aux); break;
        case 14: ph_ln(p, 2, false); break;
        case 15: ph_gemm<EPI_FFN1, 1024>(p, HB, (const bf16_t*)(p.ws + OFF_F1 + SZ_F), 4096, s_aux); break;
        case 16: ph_gemm<EPI_RESID, 4096, 2>(p, (const bf16_t*)(p.ws + OFF_U), (const bf16_t*)(p.ws + OFF_F2 + SZ_F), 1024, s_aux); break;
        case 17: ph_ln(p, 3, true); break;
    }
}

__global__ void __launch_bounds__(512, 2) k_mega(Params p) {
    bf16_t* smem = (bf16_t*)dsm;
    float* s_aux = (float*)(dsm + SMEM_BYTES);
    uint4* xbw = (uint4*)(dsm + SMEM_BYTES + 1536);
    cg::grid_group grid = cg::this_grid();
    if (opaque_tid() == 0) *xbw = make_uint4(0u, 0u, 0u, 0u);
    __syncthreads();
    const XcdBarrier xb = xcd_barrier_post((unsigned*)(p.ws + OFF_BAR), (volatile LAS unsigned*)xbw);
    if (p.ws == nullptr) grid.sync();
#define PHS(N) run_phase<N>(p, smem, s_aux); xcd_barrier(xb);
    PHS(0) PHS(1) PHS(2) PHS(3) PHS(4) PHS(5) PHS(6) PHS(7) PHS(8) PHS(9) PHS(10) PHS(11) PHS(12) PHS(13) PHS(14) PHS(15) PHS(16)
    run_phase<17>(p, smem, s_aux);
}

extern "C" void kernel_launch(void* const* d_in, const int* in_sizes, int n_in, void* d_out, int out_size, void* d_ws, size_t ws_size, hipStream_t stream) {
    Params p{};
    p.x = (const float*)d_in[0]; p.meta = (const float*)d_in[1]; p.ew_in = (const float*)d_in[2]; p.ef_bias = (const float*)d_in[3];
    p.dlam = (const float*)d_in[4]; p.subln = (const float*)d_in[5]; p.ew_out = (const float*)d_in[6]; p.rw_in = (const float*)d_in[7];
    p.rw_out = (const float*)d_in[8]; p.ln_g = (const float*)d_in[9]; p.ln_b = (const float*)d_in[10]; p.f_w1 = (const float*)d_in[11];
    p.f_w2 = (const float*)d_in[12]; p.out = (float*)d_out; p.ws = (unsigned char*)d_ws;
    if (ws_size < WS_END) { fprintf(stderr, "workspace too small: %zu < %zu\n", ws_size, (size_t)WS_END); }
    static int grid_blocks = 0;
    if (!grid_blocks) {
        int dev = 0, cus = 0, per_cu = 0;
        hipGetDevice(&dev);
        hipDeviceGetAttribute(&cus, hipDeviceAttributeMultiprocessorCount, dev);
        (void)hipFuncSetAttribute((const void*)k_mega, hipFuncAttributeMaxDynamicSharedMemorySize, DSM_BYTES);
        (void)hipOccupancyMaxActiveBlocksPerMultiprocessor(&per_cu, k_mega, NT, DSM_BYTES);
        if (per_cu < 1) fprintf(stderr, "occupancy query returned %d\n", per_cu);
        grid_blocks = cus;
    }
    void* args[] = {&p};
    (void)hipMemsetAsync((unsigned char*)d_ws + OFF_BAR, 0, 16384 + 4096, stream);
    hipError_t e = hipLaunchCooperativeKernel((void*)k_mega, dim3(grid_blocks), dim3(NT), args, DSM_BYTES, stream);
    if (e != hipSuccess) fprintf(stderr, "cooperative launch failed: %s (grid %d)\n", hipGetErrorString(e), grid_blocks);
}
```

```cpp
#include <hip/hip_runtime.h>
#include <hip/hip_cooperative_groups.h>
#include <cstdio>
#include <cstdint>
namespace cg = cooperative_groups;

#ifndef MEGA
#define MEGA 1
#endif

#define DI __device__ __forceinline__
typedef unsigned short bf16_t;
typedef __attribute__((ext_vector_type(8))) short bf16x8;
typedef __attribute__((ext_vector_type(16))) float f32x16;
typedef __attribute__((ext_vector_type(4))) float f32x4;
typedef __attribute__((ext_vector_type(2))) float f32x2;
typedef __attribute__((ext_vector_type(2))) __bf16 bf16x2v;
typedef __attribute__((ext_vector_type(4))) unsigned u32x4;
typedef __attribute__((ext_vector_type(2))) unsigned u32x2;

constexpr int BATCH = 4, LT = 8208, MT = BATCH * LT  , LP = 8320, LR = 8256, DM = 1024;
constexpr int NTM = (MT + 127) / 128;
constexpr int NCH = 129;
constexpr float LOG2E = 1.4426950408889634f;
constexpr float ALPHA = 1.4142135623730951f;

constexpr size_t SZ_W0IN = 3072ull * 1024 * 2, SZ_W0OUT = 1024ull * 1024 * 2, SZ_W1IN = 6144ull * 1024 * 2, SZ_W1OUT = 1024ull * 2048 * 2, SZ_F = 4096ull * 1024 * 2;
constexpr size_t OFF_W0IN = 0;
constexpr size_t OFF_W0OUT = OFF_W0IN + SZ_W0IN;
constexpr size_t OFF_W1IN = OFF_W0OUT + SZ_W0OUT;
constexpr size_t OFF_W1OUT = OFF_W1IN + SZ_W1IN;
constexpr size_t OFF_F1 = OFF_W1OUT + SZ_W1OUT;
constexpr size_t OFF_F2 = OFF_F1 + 2 * SZ_F;
constexpr size_t OFF_H = OFF_F2 + 2 * SZ_F;
constexpr size_t OFF_HB = OFF_H + (size_t)MT * 1024 * 4;
constexpr size_t OFF_LOGF = OFF_HB + (size_t)MT * 1024 * 2;
constexpr size_t OFF_CUMF = OFF_LOGF + (size_t)BATCH * 8 * LP * 4;
constexpr size_t OFF_MISC = OFF_CUMF + (size_t)BATCH * 8 * LP * 4;
constexpr size_t OFF_BAR = OFF_MISC + 4096;
constexpr size_t OFF_CNT = OFF_BAR + 16384;
constexpr size_t OFF_R = OFF_MISC + 32768;
constexpr size_t OFF_PQK = OFF_R;
constexpr size_t OFF_VTA = OFF_PQK + (size_t)MT * 2048 * 2;
constexpr size_t OFF_VTB = OFF_VTA + (size_t)BATCH * 512 * LP * 2;
constexpr size_t OFF_U = OFF_R;
constexpr size_t OFF_KHAT = OFF_R;
constexpr size_t OFF_KHATT = OFF_KHAT + (size_t)MT * 1024 * 2;
constexpr size_t OFF_VT1 = OFF_KHATT + (size_t)BATCH * 1024 * LR * 2;
constexpr size_t OFF_YB = OFF_KHAT;
constexpr size_t WS_END = OFF_VT1 + (size_t)BATCH * 2048 * LR * 2;
static_assert(OFF_U + (size_t)MT * 4096 * 2 <= WS_END + 4000000, "ws");
static_assert(WS_END <= 536870912ull, "ws too big");
static_assert((size_t)MT * 2048 * 2 <= (OFF_VT1 - OFF_KHAT), "yb alias");
constexpr size_t OFFO_QHAT = 0;
constexpr size_t OFFO_SBUF = OFFO_QHAT + (size_t)NCH * 16 * 64 * 256 * 2;
constexpr size_t OFFO_PART = OFFO_SBUF + (size_t)NCH * 16 * 4096 * 2;
constexpr size_t OFFO_DUMMY = OFFO_PART + (size_t)MT * 256 * 4;
static_assert(OFFO_DUMMY + 256 * 512 * 4 <= 124ull * 1048576, "out scratch");
constexpr size_t OFFO_STATS = 124ull * 1048576;
static_assert(OFFO_STATS + (size_t)MT * 8 <= 134217728ull, "out scratch");

struct Params {
    const float *x, *meta, *ew_in, *ef_bias, *dlam, *subln, *ew_out, *rw_in, *rw_out, *ln_g, *ln_b, *f_w1, *f_w2;
    float* out;
    unsigned char* ws;
};

DI unsigned cvt_pk(float lo, float hi) { f32x2 v = {lo, hi}; bf16x2v b = __builtin_convertvector(v, bf16x2v); return __builtin_bit_cast(unsigned, b); }
DI bf16_t f2bf(float x) { return (bf16_t)(cvt_pk(x, 0.f) & 0xffffu); }
DI f32x16 mfma32(bf16x8 a, bf16x8 b, f32x16 c) { return __builtin_amdgcn_mfma_f32_32x32x16_bf16(a, b, c, 0, 0, 0); }
DI int crow(int reg, int h) { return (reg & 3) + 8 * (reg >> 2) + 4 * h; }
DI int perm23(int r) { return (r & 0x13) | ((r & 4) << 1) | ((r & 8) >> 1); }
template <int S> DI bf16x8 pack8(const f32x16& x) {
    u32x4 p;
    p[0] = cvt_pk(x[8 * S + 0], x[8 * S + 1]); p[1] = cvt_pk(x[8 * S + 2], x[8 * S + 3]);
    p[2] = cvt_pk(x[8 * S + 4], x[8 * S + 5]); p[3] = cvt_pk(x[8 * S + 6], x[8 * S + 7]);
    return __builtin_bit_cast(bf16x8, p);
}
DI f32x16 zero16() { f32x16 z; for (int i = 0; i < 16; ++i) z[i] = 0.f; return z; }
DI float ex2(float x) { return __builtin_amdgcn_exp2f(x); }
DI float xsum32(float x) { auto r = __builtin_amdgcn_permlane32_swap(__float_as_uint(x), __float_as_uint(x), false, false); return __uint_as_float(r[0]) + __uint_as_float(r[1]); }
DI float xmax32(float x) { auto r = __builtin_amdgcn_permlane32_swap(__float_as_uint(x), __float_as_uint(x), false, false); return fmaxf(__uint_as_float(r[0]), __uint_as_float(r[1])); }
DI int opaque_tid() { int t = threadIdx.x; asm volatile("" : "+v"(t)); return t; }


#define XB_TMO      128
#define XB_XCNT(j)  (256  + 64 * (j))
#define XB_XSUB(j)  (1280 + 64 * (j))
#define XB_XGEN(j)  (2304 + 64 * (j))
#define XB_TOP      3328
#define XB_TOPGEN   3392
#define XCD_BAR_WORDS 3456
#define XB_SPIN_CAP (1u << 20)
#define LAS __attribute__((address_space(3)))
DI unsigned xb_ld(unsigned* p) { return __hip_atomic_load(p, __ATOMIC_RELAXED, __HIP_MEMORY_SCOPE_AGENT); }
DI unsigned xb_add(unsigned* p, unsigned v) { return __hip_atomic_fetch_add(p, v, __ATOMIC_RELAXED, __HIP_MEMORY_SCOPE_AGENT); }
DI unsigned xb_xcc_id() { return (unsigned)__builtin_amdgcn_s_getreg((3 << 11) | 20) & 0xFu; }
#define XB_SPIN(cond, bar) do { unsigned _sp = 0; while (cond) { __builtin_amdgcn_s_sleep(1); \
    if ((++_sp & 255u) == 0u) { if (xb_ld(&(bar)[XB_TMO])) break; if (_sp > XB_SPIN_CAP) { atomicAdd(&(bar)[XB_TMO], 1u); break; } } } } while (0)
struct XcdBarrier { unsigned* bar; unsigned x; volatile LAS unsigned* st; };
DI XcdBarrier xcd_barrier_post(unsigned* bar, volatile LAS unsigned* st) {
    XcdBarrier b; b.bar = bar; b.x = xb_xcc_id(); b.st = st;
    if (opaque_tid() == 0) (void)xb_add(&bar[XB_XCNT(b.x)], 1u);
    return b;
}
DI void xcd_barrier_complete(unsigned* bar, unsigned x, unsigned& nloc, unsigned& nx) {
    const unsigned G = gridDim.x * gridDim.y * gridDim.z;
    unsigned sum, cnt, mine, sp = 0u;
    for (;;) {
        sum = 0u; cnt = 0u; mine = 0u;
#pragma unroll
        for (unsigned j = 0; j < 16; ++j) { const unsigned c = xb_ld(&bar[XB_XCNT(j)]); sum += c; cnt += (c > 0u) ? 1u : 0u; mine = (j == x) ? c : mine; }
        if (sum == G) break;
        __builtin_amdgcn_s_sleep(1);
        if ((++sp & 255u) == 0u) { if (xb_ld(&bar[XB_TMO])) break; if (sp > XB_SPIN_CAP) { atomicAdd(&bar[XB_TMO], 1u); break; } }
    }
    nloc = mine > 0u ? mine : 1u; nx = cnt > 0u ? cnt : 1u;
}
DI void xcd_barrier(const XcdBarrier& b) {
    asm volatile("s_waitcnt vmcnt(0)" ::: "memory");
    __syncthreads();
    if (opaque_tid() == 0) {
        unsigned* bar = b.bar;
        __builtin_amdgcn_s_waitcnt(0);
        unsigned nloc = b.st[0], nx = b.st[1];
        if (nloc == 0u) { xcd_barrier_complete(bar, b.x, nloc, nx); b.st[0] = nloc; b.st[1] = nx; }
        const unsigned old = xb_add(&bar[XB_XSUB(b.x)], 1u);
        const unsigned gen = old / nloc;
        if (old + 1u == (gen + 1u) * nloc) {
            __builtin_amdgcn_fence(__ATOMIC_RELEASE, "agent");
            asm volatile("s_waitcnt vmcnt(0)" ::: "memory");
            const unsigned og = xb_add(&bar[XB_TOP], 1u);
            const unsigned tg = og / nx;
            if (og + 1u == (tg + 1u) * nx) xb_add(&bar[XB_TOPGEN], 1u);
            else XB_SPIN(xb_ld(&bar[XB_TOPGEN]) == tg, bar);
            __builtin_amdgcn_fence(__ATOMIC_ACQUIRE, "agent");
            xb_add(&bar[XB_XGEN(b.x)], 1u);
            asm volatile("s_waitcnt vmcnt(0)" ::: "memory");
        } else {
            XB_SPIN(xb_ld(&bar[XB_XGEN(b.x)]) == gen, bar);
            __builtin_amdgcn_fence(__ATOMIC_ACQUIRE, "agent");
            asm volatile("s_waitcnt vmcnt(0)" ::: "memory");
        }
    }
    __syncthreads();
}


DI size_t qf_off(int item, int i, int dk) { return ((size_t)(((item * 8 + (dk >> 5)) * 2 + ((dk >> 4) & 1)) * 2 + (i >> 5)) * 64 + ((dk >> 3) & 1) * 32 + (i & 31)) * 8 + (dk & 7); }
DI size_t kf_off(int item, int dk, int j) { return ((size_t)((item * 8 + (dk >> 5)) * 4 + (j >> 4)) * 64 + ((j >> 3) & 1) * 32 + perm23(dk & 31)) * 8 + (j & 7); }
DI size_t vf_off(int item, int dvh, int j) { return ((size_t)((item * 16 + (dvh >> 5)) * 4 + (j >> 4)) * 64 + ((j >> 3) & 1) * 32 + (dvh & 31)) * 8 + (j & 7); }
DI size_t sf_off(int item, int i, int j) { return ((size_t)((item * 2 + (i >> 5)) * 4 + (j >> 4)) * 64 + ((j >> 3) & 1) * 32 + (i & 31)) * 8 + (j & 7); }

constexpr int NT = 512;
constexpr int SMEM_BYTES = 131072;
constexpr int DSM_BYTES = SMEM_BYTES + 4096 + 8192;
extern __shared__ __attribute__((aligned(16))) unsigned char dsm[];

DI void transpose_tile(const float* __restrict__ src, int ld, bf16_t* __restrict__ dst, int K, int k0, int n0, float* tile) {
    const int tid = opaque_tid();
#pragma unroll 4
    for (int i = 0; i < 8; ++i) { const int k = (tid >> 6) + 8 * i, n = tid & 63; tile[k * 65 + n] = src[(size_t)(k0 + k) * ld + n0 + n]; }
    __syncthreads();
#pragma unroll 4
    for (int i = 0; i < 8; ++i) { const int n = (tid >> 6) + 8 * i, k = tid & 63; dst[(size_t)(n0 + n) * K + k0 + k] = f2bf(tile[k * 65 + n]); }
    __syncthreads();
}

DI void ph_prologue(const Params& p, bf16_t* smem) {
    float* tile = (float*)smem;
    const int tid = opaque_tid();
    auto decode = [&](int it, const float*& sp, bf16_t*& dp, int& ld, int& K) {
        const float* src; int N; bf16_t* dst; int t = it;
        if (t < 768) { src = p.ew_in; ld = 3080; K = 1024; N = 3072; dst = (bf16_t*)(p.ws + OFF_W0IN); }
        else if ((t -= 768) < 256) { src = p.ew_out; ld = 1024; K = 1024; N = 1024; dst = (bf16_t*)(p.ws + OFF_W0OUT); }
        else if ((t -= 256) < 1536) { src = p.rw_in; ld = 6144; K = 1024; N = 6144; dst = (bf16_t*)(p.ws + OFF_W1IN); }
        else if ((t -= 1536) < 512) { src = p.rw_out; ld = 1024; K = 2048; N = 1024; dst = (bf16_t*)(p.ws + OFF_W1OUT); }
        else if ((t -= 512) < 2048) { const int l = t >> 10; t &= 1023; src = p.f_w1 + (size_t)l * 1024 * 4096; ld = 4096; K = 1024; N = 4096; dst = (bf16_t*)(p.ws + OFF_F1 + l * SZ_F); }
        else { t -= 2048; const int l = t >> 10; t &= 1023; src = p.f_w2 + (size_t)l * 4096 * 1024; ld = 1024; K = 4096; N = 1024; dst = (bf16_t*)(p.ws + OFF_F2 + l * SZ_F); }
        const int ntn = N >> 6, k0 = (t / ntn) * 64, n0 = (t % ntn) * 64;
        sp = src + (size_t)k0 * ld + n0;
        dp = dst + (size_t)n0 * K + k0;
    };
    {
        const int tr = tid >> 6, tc = tid & 63;
        int it = blockIdx.x;
        const float* sp = nullptr; bf16_t* dp = nullptr; int ld = 0, K = 0;
        float pre[8];
        if (it < 7168) {
            decode(it, sp, dp, ld, K);
#pragma unroll
            for (int i = 0; i < 8; ++i) pre[i] = sp[(size_t)(tr + 8 * i) * ld + tc];
        }
        while (it < 7168) {
#pragma unroll
            for (int i = 0; i < 8; ++i) tile[(tr + 8 * i) * 65 + tc] = pre[i];
            __syncthreads();
            bf16_t* dcur = dp; const int Kcur = K;
            const int itn = it + (int)gridDim.x;
            if (itn < 7168) {
                decode(itn, sp, dp, ld, K);
#pragma unroll
                for (int i = 0; i < 8; ++i) pre[i] = sp[(size_t)(tr + 8 * i) * ld + tc];
            }
#pragma unroll
            for (int i = 0; i < 8; ++i) dcur[(size_t)(tr + 8 * i) * Kcur + tc] = f2bf(tile[tc * 65 + tr + 8 * i]);
            __syncthreads();
            it = itn;
        }
    }
    bf16_t* VT = (bf16_t*)(p.ws + OFF_VTA);
    for (int idx = blockIdx.x * NT + tid; idx < 4096 * 6; idx += gridDim.x * NT) {
        const int row = idx / 6, c = idx % 6;
        *(u32x4*)(VT + ((size_t)128 * 4096 + row) * 64 + 16 + c * 8) = (u32x4){0u, 0u, 0u, 0u};
    }
    if (blockIdx.x == 0 && tid < 64) {
        float a = p.dlam[tid] * p.dlam[64 + tid], b = p.dlam[128 + tid] * p.dlam[192 + tid];
        for (int o = 32; o > 0; o >>= 1) { a += __shfl_xor(a, o); b += __shfl_xor(b, o); }
        if (tid == 0) ((float*)(p.ws + OFF_MISC))[0] = __expf(a) - __expf(b) + 0.2f;
    }
}

enum { EPI_E1 = 0, EPI_RESID = 1, EPI_FFN1 = 2, EPI_E5 = 3, EPI_E5B = 4 };

template <int EPI, int LNI = -1>
DI void epi_store(const Params& p, int row0, int col, int lrow0, float (&v)[4], const float* s_aux, const f32x2* rs = nullptr, float gg = 1.f, float bb = 0.f) {
    const int b = row0 / LT, pos = row0 - b * LT;
    if (EPI == EPI_E1) {
        const int seg = col >> 9, cs = col & 511;
        if (seg == 2 || seg == 5) {
            bf16_t* vt = (bf16_t*)(p.ws + OFF_VTA);
            u32x2 wv; wv[0] = cvt_pk(v[0], v[1]); wv[1] = cvt_pk(v[2], v[3]);
            *(u32x2*)(vt + ((size_t)(pos >> 6) * 4096 + (seg == 2 ? 0 : 2048) + b * 512 + cs) * 64 + (pos & 63)) = wv;
        } else {
            const int oc = (seg == 0 ? 0 : seg == 1 ? 512 : seg == 3 ? 1024 : 1536) + cs;
            bf16_t* d = (bf16_t*)(p.ws + OFF_PQK) + (size_t)row0 * 2048 + oc;
#pragma unroll
            for (int e = 0; e < 4; ++e) d[(size_t)e * 2048] = f2bf(v[e]);
        }
    } else if (EPI == EPI_RESID) {
        float* d = (float*)(p.ws + OFF_H) + (size_t)row0 * 1024 + col;
#pragma unroll
        for (int e = 0; e < 4; ++e) {
            float hprev = d[(size_t)e * 1024];
            if (LNI >= 0) hprev = (hprev - rs[e][0]) * rs[e][1] * gg + bb;
            d[(size_t)e * 1024] = ALPHA * hprev + v[e];
        }
    } else if (EPI == EPI_FFN1) {
        bf16_t* d = (bf16_t*)(p.ws + OFF_U) + (size_t)row0 * 4096 + col;
#pragma unroll
        for (int e = 0; e < 4; ++e) { const float t = fmaxf(v[e], 0.f); d[(size_t)e * 4096] = f2bf(t * t); }
    } else if (EPI == EPI_E5) {
        const int idx = (pos + 48) & 63, ch = (pos + 48) >> 6;
        if (col < 1024) {
            const int hd = col >> 8, item = (ch * 4 + b) * 4 + hd;
            bf16_t* d = (bf16_t*)((unsigned char*)p.out + OFFO_QHAT) + qf_off(item, idx, col & 255);
#pragma unroll
            for (int e = 0; e < 4; ++e) d[e * 8] = f2bf(v[e] * rs[e][0]);
        } else if (col < 2048) {
            const int c = col - 1024, hd = c >> 8, item = (ch * 4 + b) * 4 + hd;
            bf16_t* d = (bf16_t*)(p.ws + OFF_KHAT) + (size_t)row0 * 1024 + c;
#pragma unroll
            for (int e = 0; e < 4; ++e) { v[e] *= rs[e][1]; d[(size_t)e * 1024] = f2bf(v[e]); }
            u32x2 wv; wv[0] = cvt_pk(v[0], v[1]); wv[1] = cvt_pk(v[2], v[3]);
            *(u32x2*)((bf16_t*)(p.ws + OFF_KHATT) + kf_off(item, c & 255, idx)) = wv;
        } else {
            const int c = col - 2048, hd = c >> 9, item = (ch * 4 + b) * 4 + hd;
            u32x2 wv; wv[0] = cvt_pk(v[0], v[1]); wv[1] = cvt_pk(v[2], v[3]);
            *(u32x2*)((bf16_t*)(p.ws + OFF_VT1) + vf_off(item, c & 511, idx)) = wv;
        }
    } else if (EPI == EPI_E5B) {
        const u32x2 ov = *(const u32x2*)((const bf16_t*)(p.ws + OFF_VT1) + vf_off((((pos + 48) >> 6) * 4 + b) * 4 + (col >> 9), col & 511, (pos + 48) & 63));
        bf16_t* d = (bf16_t*)(p.ws + OFF_YB) + (size_t)row0 * 2048 + col;
#pragma unroll
        for (int e = 0; e < 4; ++e) {
            const unsigned ob = (e & 1) ? (ov[e >> 1] & 0xffff0000u) : (ov[e >> 1] << 16);
            const float o = __uint_as_float(ob);
            const float gte = v[e] / (1.f + __expf(-v[e]));
            d[(size_t)e * 2048] = f2bf(gte * o * s_aux[lrow0 + e]);
        }
    }
}

constexpr int G_BK = 64, G_HALF = 128, G_HT = G_HALF * G_BK;
DI int lds_byte(int r, int c) { const int st = (r >> 4) * 2 + (c >> 5), rr = r & 15, cc = c & 31, ob = rr * 64 + cc * 2; return st * 1024 + (ob ^ (((ob >> 9) & 1) << 5)); }
DI void stage_rc(int b, int& R, int& C) { const int st = b / 1024, sb = b % 1024, swz = sb ^ (((sb >> 9) & 1) << 5); R = (st >> 1) * 16 + swz / 64; C = (st & 1) * 32 + (swz % 64) / 2; }

template <int EPI, int K, int LNI>
DI void gemm_tail_unit(const Params& p, const bf16_t* __restrict__ A, const bf16_t* __restrict__ Bt, const int un, float* s_aux) {
    const int tid = opaque_tid(), lane = tid & 63, w = tid >> 6, r = lane & 31, h = lane >> 5;
    constexpr int ROW0 = 32768, KS = K / 8;
    const int col0 = un * 64;
    if (EPI == EPI_E5B) {
        if (tid < 64) {
            const int hd = col0 >> 9;
            const float* pp = (const float*)((unsigned char*)p.out + OFFO_PART) + (size_t)(ROW0 + tid) * 256 + hd * 64;
            float sacc = 0.f;
#pragma unroll
            for (int i = 0; i < 16; ++i) { const f32x4 v = *(const f32x4*)(pp + i * 4); sacc += (v[0] + v[1]) + (v[2] + v[3]); }
            s_aux[tid] = __frsqrt_rn(sacc * (1.0f / 512.0f) + 1e-6f);
        }
    }
    f32x16 acc[2][2];
    acc[0][0] = zero16(); acc[0][1] = zero16(); acc[1][0] = zero16(); acc[1][1] = zero16();
    const bf16_t* ap = A + (size_t)(ROW0 + r) * K + w * KS + h * 8;
    const bf16_t* bp = Bt + (size_t)(col0 + r) * K + w * KS + h * 8;
#pragma unroll 8
    for (int s = 0; s < KS / 16; ++s) {
        const bf16x8 a0 = *(const bf16x8*)(ap + s * 16), a1 = *(const bf16x8*)(ap + (size_t)32 * K + s * 16);
        const bf16x8 b0 = *(const bf16x8*)(bp + s * 16), b1 = *(const bf16x8*)(bp + (size_t)32 * K + s * 16);
        acc[0][0] = mfma32(a0, b0, acc[0][0]); acc[0][1] = mfma32(a0, b1, acc[0][1]);
        acc[1][0] = mfma32(a1, b0, acc[1][0]); acc[1][1] = mfma32(a1, b1, acc[1][1]);
    }
    float* red = (float*)dsm;
#pragma unroll
    for (int i = 0; i < 2; ++i)
#pragma unroll
        for (int j = 0; j < 2; ++j)
#pragma unroll
            for (int reg = 0; reg < 16; ++reg) red[((w * 4 + i * 2 + j) * 16 + reg) * 64 + lane] = acc[i][j][reg];
    __syncthreads();
    {
        const int tile = w >> 1, i = tile >> 1, j = tile & 1;
#pragma unroll
        for (int gg = 0; gg < 2; ++gg) {
            const int g = 2 * (w & 1) + gg;
            float v[4];
#pragma unroll
            for (int e = 0; e < 4; ++e) {
                float sacc = 0.f;
#pragma unroll
                for (int wv = 0; wv < 8; ++wv) sacc += red[((wv * 4 + tile) * 16 + 4 * g + e) * 64 + lane];
                v[e] = sacc;
            }
            const int lrow0 = i * 32 + 8 * g + 4 * h;
            f32x2 rs[4]; float lng = 1.f, lnb = 0.f;
            if (EPI == EPI_E5) {
                lng = log2f(1.f - ex2(-5.f - (float)((col0 >> 8) & 3)));
                const int idx_ = (((ROW0 + lrow0) % LT) + 48) & 63;
#pragma unroll
                for (int e = 0; e < 4; ++e) rs[e] = (f32x2){ex2(lng * (float)(idx_ + e + 1)), 0.0625f * ex2(lng * (float)(63 - idx_ - e))};
            }
            if (EPI == EPI_RESID && LNI >= 0) {
                const f32x2* st_ = (const f32x2*)((unsigned char*)p.out + OFFO_STATS) + ROW0 + lrow0;
#pragma unroll
                for (int e = 0; e < 4; ++e) rs[e] = st_[e];
                lng = p.ln_g[(LNI < 0 ? 0 : LNI) * 1024 + col0 + j * 32 + r]; lnb = p.ln_b[(LNI < 0 ? 0 : LNI) * 1024 + col0 + j * 32 + r];
            }
            epi_store<EPI, LNI>(p, ROW0 + lrow0, col0 + j * 32 + r, lrow0, v, s_aux, rs, lng, lnb);
        }
    }
    __syncthreads();
}

template <int EPI, int K, int LNI = -1>
DI void ph_gemm(const Params& p, const bf16_t* __restrict__ A, const bf16_t* __restrict__ Bt, int N, float* s_aux) {
    constexpr int NXCD = 8, WGM = 8;
    const int nM = 128, nN = N / 256, nwg = nM * nN;
    auto unit = [&](int it, int& pm, int& pn) {
        int wgid = it;
        { const int q = nwg / NXCD, r = nwg % NXCD, xcd = wgid % NXCD, off = wgid / NXCD; wgid = (xcd < r ? xcd * (q + 1) : r * (q + 1) + (xcd - r) * q) + off; }
        const int nig = WGM * nN, gid = wgid / nig, fm = gid * WGM, gsz = min(nM - fm, WGM);
        pm = fm + ((wgid % nig) % gsz); pn = (wgid % nig) / gsz;
    };
    bf16_t* shm = (bf16_t*)dsm;
    typedef __attribute__((address_space(3))) unsigned lds_u32;
    typedef __attribute__((address_space(3))) unsigned char lds_u8;
#define SA(b, h) (shm + ((b) * 2 + (h)) * G_HT)
#define SB(b, h) (shm + (4 + (b) * 2 + (h)) * G_HT)
#define STAGE(P, g) do { const char* g_ = (const char*)(g); \
        __builtin_amdgcn_global_load_lds((const unsigned*)(g_ + so0), (lds_u32*)((lds_u8*)(P) + sb0), 16, 0, 0); \
        __builtin_amdgcn_global_load_lds((const unsigned*)(g_ + so1), (lds_u32*)((lds_u8*)(P) + sb0 + 8192), 16, 0, 0); } while (0)
#define LDA(dst, b, h) for (int m = 0; m < 4; ++m) for (int k = 0; k < 2; ++k) \
        dst[m][k] = *reinterpret_cast<const bf16x8*>((char*)SA(b, h) + lds_byte(wr * 64 + m * 16 + fr, k * 32 + fq * 8))
#define LDB(dst, b, h) for (int n = 0; n < 2; ++n) for (int k = 0; k < 2; ++k) \
        dst[n][k] = *reinterpret_cast<const bf16x8*>((char*)SB(b, h) + lds_byte(wc * 32 + n * 16 + fr, k * 32 + fq * 8))
#define MMA(ai, bj, At_, Bt_) do { __builtin_amdgcn_s_setprio(1); \
        for (int m = 0; m < 4; ++m) for (int n = 0; n < 2; ++n) for (int k = 0; k < 2; ++k) \
            acc[ai][bj][m][n] = __builtin_amdgcn_mfma_f32_16x16x32_bf16(At_[m][k], Bt_[n][k], acc[ai][bj][m][n], 0, 0, 0); \
        __builtin_amdgcn_s_setprio(0); } while (0)
#define WAIT_V(n) asm volatile("s_waitcnt vmcnt(" #n ")" ::: "memory")
#define WAIT_L(n) asm volatile("s_waitcnt lgkmcnt(" #n ")" ::: "memory")
#define BAR __builtin_amdgcn_s_barrier()
#define SCHED __builtin_amdgcn_sched_barrier(0)
    const int wid = opaque_tid() >> 6, lane = opaque_tid() & 63, wr = wid >> 2, wc = wid & 3, fr = lane & 15, fq = lane >> 4;
    const int sb0 = opaque_tid() * 16;
    unsigned so0, so1;
    { int r_, c_; stage_rc(sb0, r_, c_); so0 = (unsigned)(r_ * K + c_) * 2u; stage_rc(sb0 + 8192, r_, c_); so1 = (unsigned)(r_ * K + c_) * 2u; }
    constexpr int nt = K / G_BK;
    constexpr size_t hstep = (size_t)G_HALF * K, kstep = G_BK;

    int it = blockIdx.x, pm, pn;
    unit(it, pm, pn);
    const bf16_t* cA = A + (size_t)pm * 256 * K; const bf16_t* cB = Bt + (size_t)pn * 256 * K;
    STAGE(SB(0, 0), cB); STAGE(SB(0, 1), cB + hstep); STAGE(SA(0, 0), cA); STAGE(SA(0, 1), cA + hstep);
    if (wr == 1) BAR;
    WAIT_V(2); BAR;
    STAGE(SB(1, 0), cB + kstep); STAGE(SA(1, 0), cA + kstep); STAGE(SB(1, 1), cB + hstep + kstep);
    WAIT_V(6); BAR;
    f32x4 acc[2][2][4][2] = {};
    bf16x8 At[4][2], B0[2][2], B1[2][2];
    int cnt = 0;
    for (;;) {
        const int itn = it + (int)gridDim.x;
        const bool has_next = itn < nwg;
        int npm = pm, npn = pn;
        if (has_next) unit(itn, npm, npn);
        const bf16_t* nA = A + (size_t)npm * 256 * K; const bf16_t* nB = Bt + (size_t)npn * 256 * K;
        const int brow = pm * 256, bcol = pn * 256;
        float* sa = s_aux + (cnt & 1) * 512;
        if (EPI == EPI_E5B) {
            if (opaque_tid() < 256) {
                const int row = brow + (int)opaque_tid(); const int hd = bcol >> 9;
                const float* pp = (const float*)((unsigned char*)p.out + OFFO_PART) + (size_t)row * 256 + hd * 64;
                float sacc = 0.f;
#pragma unroll
                for (int i = 0; i < 16; ++i) { const f32x4 v = *(const f32x4*)(pp + i * 4); sacc += (v[0] + v[1]) + (v[2] + v[3]); }
                sa[opaque_tid()] = __frsqrt_rn(sacc * (1.0f / 512.0f) + 1e-6f);
            }
        }
        for (int t = 0; t < nt; t += 2) {
            const bool last = (t == nt - 2);
            const bf16_t* a1 = cA + (size_t)(t + 1) * kstep;
            const bf16_t* a2 = last ? nA : cA + (size_t)(t + 2) * kstep; const bf16_t* b2 = last ? nB : cB + (size_t)(t + 2) * kstep;
            const bf16_t* a3 = a2 + kstep; const bf16_t* b3 = b2 + kstep;
            LDB(B0, 0, 0); LDB(B1, 0, 1); SCHED; LDA(At, 0, 0); STAGE(SA(1, 1), a1 + hstep);
            WAIT_V(8); WAIT_L(0); BAR; MMA(0, 0, At, B0); MMA(0, 1, At, B1); BAR; SCHED;
            LDA(At, 0, 1); STAGE(SB(0, 0), b2); STAGE(SB(0, 1), b2 + hstep); STAGE(SA(0, 0), a2);
            WAIT_V(8); WAIT_L(0); BAR; MMA(1, 0, At, B0); MMA(1, 1, At, B1); BAR; SCHED;
            LDB(B0, 1, 0); LDB(B1, 1, 1); SCHED; LDA(At, 1, 0); STAGE(SA(0, 1), a2 + hstep);
            WAIT_V(8); WAIT_L(0); BAR; MMA(0, 0, At, B0); MMA(0, 1, At, B1); BAR; SCHED;
            LDA(At, 1, 1); STAGE(SB(1, 0), b3); STAGE(SB(1, 1), b3 + hstep); STAGE(SA(1, 0), a3);
            WAIT_V(8); WAIT_L(0); BAR; MMA(1, 0, At, B0); MMA(1, 1, At, B1); BAR; SCHED;
        }
        if (wr == 0) BAR;
        {
            int oz = 0; asm volatile("" : "+v"(oz));
            float lg_[2][2], lb_[2][2];
#pragma unroll
            for (int bj = 0; bj < 2; ++bj)
#pragma unroll
                for (int n = 0; n < 2; ++n) {
                    lg_[bj][n] = 1.f; lb_[bj][n] = 0.f;
                    if (EPI == EPI_E5) lg_[bj][n] = log2f(1.f - ex2(-5.f - (float)((bcol >> 8) & 3)));
                    if (EPI == EPI_RESID && LNI >= 0) { const int c_ = bcol + bj * 128 + wc * 32 + n * 16 + fr; lg_[bj][n] = p.ln_g[(LNI < 0 ? 0 : LNI) * 1024 + c_]; lb_[bj][n] = p.ln_b[(LNI < 0 ? 0 : LNI) * 1024 + c_]; }
                }
#pragma unroll
            for (int ai = 0; ai < 2; ++ai)
#pragma unroll
                for (int m = 0; m < 4; ++m) {
                    const int lrow0 = ai * 128 + wr * 64 + m * 16 + fq * 4, row0 = brow + lrow0 + oz;
                    f32x2 rs[4];
                    if (EPI == EPI_RESID && LNI >= 0) {
                        const f32x2* st_ = (const f32x2*)((unsigned char*)p.out + OFFO_STATS) + row0;
#pragma unroll
                        for (int e = 0; e < 4; ++e) rs[e] = st_[e];
                    }
                    if (EPI == EPI_E5) {
                        const int idx_ = ((row0 % LT) + 48) & 63; const float lgh = lg_[0][0];
#pragma unroll
                        for (int e = 0; e < 4; ++e) rs[e] = (f32x2){ex2(lgh * (float)(idx_ + e + 1)), 0.0625f * ex2(lgh * (float)(63 - idx_ - e))};
                    }
#pragma unroll
                    for (int bj = 0; bj < 2; ++bj)
#pragma unroll
                        for (int n = 0; n < 2; ++n) {
                            float v[4];
#pragma unroll
                            for (int e = 0; e < 4; ++e) v[e] = acc[ai][bj][m][n][e];
                            epi_store<EPI, LNI>(p, row0, bcol + bj * 128 + wc * 32 + n * 16 + fr + oz, lrow0, v, sa, rs, lg_[bj][n], lb_[bj][n]);
                        }
                }
        }
        if (!has_next) break;
#pragma unroll
        for (int a = 0; a < 2; ++a)
#pragma unroll
            for (int b = 0; b < 2; ++b)
#pragma unroll
                for (int m = 0; m < 4; ++m)
#pragma unroll
                    for (int n = 0; n < 2; ++n) acc[a][b][m][n] = (f32x4){0.f, 0.f, 0.f, 0.f};
        pm = npm; pn = npn; cA = nA; cB = nB; it = itn; ++cnt;
        if (wr == 1) BAR;
    }
    WAIT_V(0);
    BAR;
#undef SA
#undef SB
#undef STAGE
#undef LDA
#undef LDB
#undef MMA
    __syncthreads();
    for (int un = blockIdx.x; un < N / 64; un += gridDim.x) gemm_tail_unit<EPI, K, LNI>(p, A, Bt, un, s_aux);
}

DI void ph_fb(const Params& p) {
    const int lane = opaque_tid() & 63;
    const int gw = blockIdx.x * 8 + (opaque_tid() >> 6), nw = gridDim.x * 8;
    float* H = (float*)(p.ws + OFF_H); bf16_t* HB = (bf16_t*)(p.ws + OFF_HB);
    float* LF = (float*)(p.ws + OFF_LOGF);
    f32x4 w0[4][4], w1[4][4];
#pragma unroll
    for (int i = 0; i < 4; ++i)
#pragma unroll
        for (int e = 0; e < 4; ++e) {
            const float* wp = p.ew_in + (size_t)(256 * i + 4 * lane + e) * 3080 + 3072;
            w0[i][e] = *(const f32x4*)wp; w1[i][e] = *(const f32x4*)(wp + 4);
        }
    const int j8 = ((lane >> 5) & 1) * 4 + ((lane >> 4) & 1) * 2 + ((lane >> 3) & 1);
    const float fbias = p.ef_bias[j8];
    for (int m = gw; m < MT; m += nw) {
        const int b_ = m / LT, pos_ = m - b_ * LT;
        const float* hrow = pos_ < 16 ? p.meta + (size_t)pos_ * 1024 : p.x + ((size_t)b_ * 8192 + (pos_ - 16)) * 1024;
        f32x4 hv[4];
#pragma unroll
        for (int i = 0; i < 4; ++i) hv[i] = *(const f32x4*)(hrow + 256 * i + 4 * lane);
#pragma unroll
        for (int i = 0; i < 4; ++i) {
            *(f32x4*)(H + (size_t)m * 1024 + 256 * i + 4 * lane) = hv[i];
            u32x2 wv; wv[0] = cvt_pk(hv[i][0], hv[i][1]); wv[1] = cvt_pk(hv[i][2], hv[i][3]);
            *(u32x2*)(HB + (size_t)m * 1024 + 256 * i + 4 * lane) = wv;
        }
        float a[8];
#pragma unroll
        for (int j = 0; j < 8; ++j) a[j] = 0.f;
#pragma unroll
        for (int i = 0; i < 4; ++i)
#pragma unroll
            for (int e = 0; e < 4; ++e) {
                const float x = hv[i][e];
                a[0] += x * w0[i][e][0]; a[1] += x * w0[i][e][1]; a[2] += x * w0[i][e][2]; a[3] += x * w0[i][e][3];
                a[4] += x * w1[i][e][0]; a[5] += x * w1[i][e][1]; a[6] += x * w1[i][e][2]; a[7] += x * w1[i][e][3];
            }
        const bool b5 = (lane & 32) != 0, b4 = (lane & 16) != 0, b3 = (lane & 8) != 0;
        float c4[4];
#pragma unroll
        for (int j = 0; j < 4; ++j) { const float send = b5 ? a[j] : a[j + 4]; const float keep = b5 ? a[j + 4] : a[j]; c4[j] = keep + __shfl_xor(send, 32); }
        float c2[2];
#pragma unroll
        for (int j = 0; j < 2; ++j) { const float send = b4 ? c4[j] : c4[j + 2]; const float keep = b4 ? c4[j + 2] : c4[j]; c2[j] = keep + __shfl_xor(send, 16); }
        float v;
        { const float send = b3 ? c2[0] : c2[1]; const float keep = b3 ? c2[1] : c2[0]; v = keep + __shfl_xor(send, 8); }
        v += __shfl_xor(v, 4); v += __shfl_xor(v, 2); v += __shfl_xor(v, 1);
        if ((lane & 7) == 0) {
            const float xx = v + fbias;
            const float ls = fminf(xx, 0.f) - log1pf(expf(-fabsf(xx)));
            const int b = m / LT, pos = m - b * LT;
            LF[(size_t)(b * 8 + j8) * LP + pos] = ls;
        }
    }
}

DI void ph_cumsum(const Params& p, bf16_t* smem) {
    float* sm = (float*)smem;
    const int tid = opaque_tid(), lane = tid & 63, w = tid >> 6;
    const float* LF = (const float*)(p.ws + OFF_LOGF);
    float* CF = (float*)(p.ws + OFF_CUMF);
    for (int it = blockIdx.x; it < 32; it += gridDim.x) {
        const float* src = LF + (size_t)it * LP; float* dst = CF + (size_t)it * LP;
        const int p0 = tid * 17;
        float v[17];
#pragma unroll
        for (int i = 0; i < 17; ++i) { const int pos = p0 + i; v[i] = (pos < LT) ? src[pos] : 0.f; }
        float s = 0.f;
#pragma unroll
        for (int i = 0; i < 17; ++i) s += v[i];
        float incl = s;
#pragma unroll
        for (int o = 1; o < 64; o <<= 1) { const float t = __shfl_up(incl, o); if (lane >= o) incl += t; }
        __syncthreads();
        if (lane == 63) sm[w] = incl;
        __syncthreads();
        float run = incl - s;
        for (int w2 = 0; w2 < w; ++w2) run += sm[w2];
#pragma unroll
        for (int i = 0; i < 17; ++i) { const int pos = p0 + i; run += v[i]; if (pos < LP) dst[pos] = run * LOG2E; }
    }
}

template <int DV, bool FOX>
DI void flash(f32x16 (&O)[DV / 32], const bf16_t* __restrict__ qptr, const bf16_t* __restrict__ kg, const bf16_t* __restrict__ vtg,
              int ntiles, int q, float slope2, const float* __restrict__ cum2, float KN, bf16_t* smem) {
    constexpr int NDT = DV / 32;
    constexpr int KS_ELEMS = 64 * 72, VS_ELEMS = DV * 72, BUF = KS_ELEMS + VS_ELEMS;
    const int tid = opaque_tid(), lane = tid & 63, r = lane & 31, h = lane >> 5;
    const int w = tid >> 6;
    const int pr = perm23(r);
    const int cc = tid & 7, r0 = tid >> 3;
    int* flags = (int*)(dsm + SMEM_BYTES - 256);
    bf16x8 qf[4];
#pragma unroll
    for (int ks = 0; ks < 4; ++ks) qf[ks] = *(const bf16x8*)(qptr + ks * 16 + h * 8);
    float qn2 = 0.f;
#pragma unroll
    for (int ks = 0; ks < 4; ++ks)
#pragma unroll
        for (int j = 0; j < 8; ++j) { const float x = __uint_as_float(((unsigned)(unsigned short)qf[ks][j]) << 16); qn2 += x * x; }
    qn2 = xsum32(qn2);
    const float c1 = 0.125f * LOG2E;
    const float sbound = sqrtf(qn2) * KN * c1 * 1.001f + 0.01f;
    float m = -1e30f, l = 0.f;
#pragma unroll
    for (int dt = 0; dt < NDT; ++dt) O[dt] = zero16();
    const float cq = FOX ? cum2[min(q, LT - 1)] : 0.f;
    const int kend = FOX ? q + 1 : 16 + 64 * ((q + 48) >> 6);
    const int wkend = __builtin_amdgcn_readfirstlane(FOX ? (q | 31) + 1 : 16 + 64 * (((q | 31) + 48) >> 6));
    const int qlo = __builtin_amdgcn_readfirstlane(q & ~31);

    constexpr int NVR = DV / 64;
    constexpr int TPB = FOX ? 3 : 2;
    u32x4 kr[TPB], vr[TPB][NVR];
#define LOAD_PAIR(ktA) do { _Pragma("unroll") for (int j_ = 0; j_ < TPB; ++j_) { const int kt_ = (ktA) - j_; if (kt_ >= 0) { const int kb_ = kt_ * 64; \
        { const int krow = min(kb_ + r0, LT - 1); kr[j_] = *(const u32x4*)(kg + (size_t)krow * 2048 + cc * 8); } \
        _Pragma("unroll") for (int i = 0; i < NVR; ++i) vr[j_][i] = *(const u32x4*)(vtg + ((size_t)kt_ * 4096 + r0 + 64 * i) * 64 + cc * 8); } } } while (0)
#define STORE_PAIR(stage) do { _Pragma("unroll") for (int j_ = 0; j_ < TPB; ++j_) { bf16_t* Kd = smem + ((stage) * TPB + j_) * BUF; bf16_t* Vd = Kd + KS_ELEMS; \
        *(u32x4*)(Kd + r0 * 72 + cc * 8) = kr[j_]; \
        _Pragma("unroll") for (int i = 0; i < NVR; ++i) *(u32x4*)(Vd + (r0 + 64 * i) * 72 + cc * 8) = vr[j_][i]; } } while (0)
#pragma unroll
    for (int j = 0; j < TPB; ++j) {
        kr[j] = (u32x4){0u, 0u, 0u, 0u};
#pragma unroll
        for (int i = 0; i < NVR; ++i) vr[j][i] = (u32x4){0u, 0u, 0u, 0u};
    }
    LOAD_PAIR(ntiles - 1);
    STORE_PAIR(0);
    __syncthreads();
    bool wskip = false;
    const int npairs = (ntiles + TPB - 1) / TPB;
    for (int pit = 0; pit < npairs; ++pit) {
        const int kt0 = ntiles - 1 - TPB * pit;
        const int cur = pit & 1;
        const bool more = pit + 1 < npairs;
        if (more) LOAD_PAIR(kt0 - TPB);
        float ckl0 = 0.f, ckl1 = 0.f, ckl2 = 0.f;
        if (FOX) { if (kt0 > 0) ckl0 = cum2[kt0 * 64 - 1]; if (kt0 > 1) ckl1 = cum2[(kt0 - 1) * 64 - 1]; if (TPB > 2 && kt0 > 2) ckl2 = cum2[(kt0 - 2) * 64 - 1]; }
#pragma unroll 1
        for (int pj = 0; pj < TPB; ++pj) {
        const int kt = kt0 - pj;
        if (kt < 0) break;
        const bf16_t* Ks = smem + (cur * TPB + pj) * BUF; const bf16_t* Vs = Ks + KS_ELEMS;
        const int kb = kt * 64;
        const float cklast = pj == 0 ? ckl0 : (pj == 1 ? ckl1 : ckl2);
        if (kb < wkend && !wskip) {
        f32x16 s[2];
#pragma unroll
        for (int sub = 0; sub < 2; ++sub) {
            s[sub] = zero16();
#pragma unroll
            for (int ks = 0; ks < 4; ++ks) {
                const bf16x8 a = *(const bf16x8*)(Ks + (sub * 32 + pr) * 72 + ks * 16 + h * 8);
                s[sub] = mfma32(a, qf[ks], s[sub]);
            }
        }
        float mx = -INFINITY;
        if (kb + 63 < qlo) {
#pragma unroll
            for (int sub = 0; sub < 2; ++sub) {
#pragma unroll
                for (int i8 = 0; i8 < 2; ++i8) {
                    const int k0 = kb + sub * 32 + 16 * i8 + 8 * h;
                    float ck[8];
                    float base = 0.f;
                    if (FOX) {
                        const f32x4 c0 = *(const f32x4*)(cum2 + k0), c1v = *(const f32x4*)(cum2 + k0 + 4);
                        ck[0] = c0[0]; ck[1] = c0[1]; ck[2] = c0[2]; ck[3] = c0[3]; ck[4] = c1v[0]; ck[5] = c1v[1]; ck[6] = c1v[2]; ck[7] = c1v[3];
                    } else base = -slope2 * (float)(q - k0);
#pragma unroll
                    for (int e = 0; e < 8; ++e) {
                        const float bias = FOX ? cq - ck[e] : fmaf(slope2, (float)e, base);
                        const float t = fmaf(s[sub][8 * i8 + e], c1, bias);
                        s[sub][8 * i8 + e] = t;
                        mx = fmaxf(mx, t);
                    }
                }
            }
        } else {
#pragma unroll
            for (int sub = 0; sub < 2; ++sub) {
#pragma unroll
                for (int i8 = 0; i8 < 2; ++i8) {
                    const int k0 = kb + sub * 32 + 16 * i8 + 8 * h;
                    float ck[8];
                    if (FOX) {
                        const f32x4 c0 = *(const f32x4*)(cum2 + k0), c1v = *(const f32x4*)(cum2 + k0 + 4);
                        ck[0] = c0[0]; ck[1] = c0[1]; ck[2] = c0[2]; ck[3] = c0[3]; ck[4] = c1v[0]; ck[5] = c1v[1]; ck[6] = c1v[2]; ck[7] = c1v[3];
                    }
#pragma unroll
                    for (int e = 0; e < 8; ++e) {
                        const int k = k0 + e;
                        float t = s[sub][8 * i8 + e] * c1;
                        if (FOX) t += cq - ck[e];
                        else t -= slope2 * fabsf((float)(q - k));
                        t = (k < kend) ? t : -INFINITY;
                        s[sub][8 * i8 + e] = t;
                        mx = fmaxf(mx, t);
                    }
                }
            }
        }
        mx = xmax32(mx);
        const float mn = fmaxf(m, mx);
        if (__any(mn > m)) {
            const float alpha = ex2(m - mn);
            l *= alpha;
#pragma unroll
            for (int dt = 0; dt < NDT; ++dt)
#pragma unroll
                for (int i = 0; i < 16; ++i) O[dt][i] *= alpha;
        }
        m = mn;
#pragma unroll
        for (int sub = 0; sub < 2; ++sub)
#pragma unroll
            for (int i = 0; i < 16; ++i) { const float pv = ex2(s[sub][i] - mn); s[sub][i] = pv; l += pv; }
        bf16x8 pf[2][2];
        pf[0][0] = pack8<0>(s[0]); pf[0][1] = pack8<1>(s[0]); pf[1][0] = pack8<0>(s[1]); pf[1][1] = pack8<1>(s[1]);
#pragma unroll
        for (int dt = 0; dt < NDT; ++dt)
#pragma unroll
            for (int sub = 0; sub < 2; ++sub)
#pragma unroll
                for (int s2 = 0; s2 < 2; ++s2) {
                    const bf16x8 a = *(const bf16x8*)(Vs + (dt * 32 + r) * 72 + sub * 32 + 16 * s2 + 8 * h);
                    O[dt] = mfma32(a, pf[sub][s2], O[dt]);
                }
        }
        if (kt > 0) {
            const int klast = kb - 1;
            float bm = 0.f;
            if (klast < q) bm = FOX ? cq - cklast : -slope2 * (float)(q - klast);
            const bool pred = (q >= LT) || (sbound + bm < m - 152.f);
            wskip = __all(pred);
        }
        }
        if (more) {
            if (lane == 0) flags[cur * 8 + w] = wskip ? 1 : 0;
            STORE_PAIR(cur ^ 1);
        }
        __syncthreads();
        if (more) {
            const int4 f0 = *(const int4*)(flags + cur * 8), f1 = *(const int4*)(flags + cur * 8 + 4);
            if ((f0.x & f0.y & f0.z & f0.w & f1.x & f1.y & f1.z & f1.w) != 0) break;
        }
    }
#undef LOAD_PAIR
#undef STORE_PAIR
    l = xsum32(l);
    const float inv = 1.0f / l;
#pragma unroll
    for (int dt = 0; dt < NDT; ++dt)
#pragma unroll
        for (int i = 0; i < 16; ++i) O[dt][i] *= inv;
}

DI void ph_knorm(const Params& p) {
    const int tid = opaque_tid(), lane = tid & 63;
    const int gw = blockIdx.x * 8 + (tid >> 6), nw = gridDim.x * 8;
    const bf16_t* PQK = (const bf16_t*)(p.ws + OFF_PQK);
    unsigned* knm = (unsigned*)(p.ws + OFF_CNT) + 128;
    for (int u = gw; u < BATCH * 513; u += nw) {
        const int b = u / 513, ch = u - b * 513;
        float mxa = 0.f, mxb = 0.f;
        const bf16_t* base = PQK + ((size_t)b * LT + ch * 16) * 2048 + lane * 8;
#pragma unroll
        for (int i = 0; i < 16; ++i) {
            const u32x4 va = *(const u32x4*)(base + (size_t)i * 2048 + 512), vb = *(const u32x4*)(base + (size_t)i * 2048 + 1536);
            float sa = 0.f, sb = 0.f;
#pragma unroll
            for (int e = 0; e < 4; ++e) {
                const float a0 = __uint_as_float(va[e] << 16), a1 = __uint_as_float(va[e] & 0xffff0000u);
                const float b0 = __uint_as_float(vb[e] << 16), b1 = __uint_as_float(vb[e] & 0xffff0000u);
                sa += a0 * a0 + a1 * a1; sb += b0 * b0 + b1 * b1;
            }
            sa += __shfl_xor(sa, 1); sa += __shfl_xor(sa, 2); sa += __shfl_xor(sa, 4);
            sb += __shfl_xor(sb, 1); sb += __shfl_xor(sb, 2); sb += __shfl_xor(sb, 4);
            mxa = fmaxf(mxa, sa); mxb = fmaxf(mxb, sb);
        }
        if ((lane & 7) == 0) {
            atomicMax(knm + b * 16 + (lane >> 3), __float_as_uint(mxa));
            atomicMax(knm + b * 16 + 8 + (lane >> 3), __float_as_uint(mxb));
        }
    }
}

DI void ph_attn(const Params& p, bf16_t* smem, int* s_item) {
    const int tid = opaque_tid(), lane = tid & 63, w = tid >> 6, r = lane & 31, h = lane >> 5;
    const bf16_t* PQK = (const bf16_t*)(p.ws + OFF_PQK);
    bf16_t* MIX = (bf16_t*)(p.ws + OFF_HB);
    const float lam = ((const float*)(p.ws + OFF_MISC))[0];
    unsigned* ctr = (unsigned*)(p.ws + OFF_CNT);
    const unsigned* knm = (const unsigned*)(p.ws + OFF_CNT) + 128;
    constexpr int NQB = 33, NDIFF = NQB * 16, NITEM = NQB * 48;
    for (;;) {
        __syncthreads();
        if (tid == 0) *s_item = (int)atomicAdd(ctr, 1u);
        __syncthreads();
        const int it = *s_item;
        if (it >= NITEM) break;
        const int cls = it / 132, jj = it - cls * 132;
        const int code = (int)((0xBA7654932108ull >> (4 * (11 - cls))) & 15ull);
        const int qbi = NQB - 1 - (jj >> 2), bi = jj & 3;
        if (code & 8) {
            const int qb = qbi;
            const int q = qb * 256 + w * 32 + r;
            const int b = bi, hd = code & 7;
            const int ntiles = (min(LT, qb * 256 + 272) + 63) >> 6;
            const size_t qrow = (size_t)b * LT + min(q, LT - 1);
            const float slope2 = ex2(-2.f * (float)(hd + 1)) * LOG2E;
            const bf16_t* vt = (const bf16_t*)(p.ws + OFF_VTA) + (size_t)(b * 512 + hd * 128) * 64;
            f32x16 O0[4];
            float* scr = p.out + (size_t)blockIdx.x * 32768 + tid * 64;
            flash<128, false>(O0, PQK + qrow * 2048 + hd * 128, PQK + (size_t)b * LT * 2048 + 512 + hd * 128, vt, ntiles, q, slope2, nullptr, sqrtf(__uint_as_float(knm[b * 16 + hd * 2])), smem);
#pragma unroll
            for (int dt = 0; dt < 4; ++dt)
#pragma unroll
                for (int g = 0; g < 4; ++g) *(f32x4*)(scr + dt * 16 + 4 * g) = (f32x4){O0[dt][4 * g], O0[dt][4 * g + 1], O0[dt][4 * g + 2], O0[dt][4 * g + 3]};
            flash<128, false>(O0, PQK + qrow * 2048 + hd * 128 + 64, PQK + (size_t)b * LT * 2048 + 512 + hd * 128 + 64, vt, ntiles, q, slope2, nullptr, sqrtf(__uint_as_float(knm[b * 16 + hd * 2 + 1])), smem);
            float ss = 0.f;
#pragma unroll
            for (int dt = 0; dt < 4; ++dt)
#pragma unroll
                for (int g = 0; g < 4; ++g) {
                    const f32x4 pv = *(const f32x4*)(scr + dt * 16 + 4 * g);
#pragma unroll
                    for (int e = 0; e < 4; ++e) { const float o = pv[e] - lam * O0[dt][4 * g + e]; O0[dt][4 * g + e] = o; ss += o * o; }
                }
            ss = xsum32(ss);
            const float rn = __frsqrt_rn(ss * (1.0f / 128.0f) + 1e-6f) * 0.8f;
            if (q < LT) {
                bf16_t* d = MIX + qrow * 1024 + hd * 128;
#pragma unroll
                for (int dt = 0; dt < 4; ++dt)
#pragma unroll
                    for (int g = 0; g < 4; ++g) {
                        const int dv = dt * 32 + 8 * g + 4 * h;
                        const f32x4 gg = *(const f32x4*)(p.subln + dv);
                        u32x2 wv; wv[0] = cvt_pk(O0[dt][4 * g] * rn * gg[0], O0[dt][4 * g + 1] * rn * gg[1]);
                        wv[1] = cvt_pk(O0[dt][4 * g + 2] * rn * gg[2], O0[dt][4 * g + 3] * rn * gg[3]);
                        *(u32x2*)(d + dv) = wv;
                    }
            }
        } else {
            const int qb = qbi;
            const int q = qb * 256 + w * 32 + r;
            const int b = bi, hf = code & 7;
            const int ntiles = (min(LT, qb * 256 + 256) + 63) >> 6;
            const size_t qrow = (size_t)b * LT + min(q, LT - 1);
            const bf16_t* vt = (const bf16_t*)(p.ws + OFF_VTA) + (size_t)(2048 + b * 512 + hf * 64) * 64;
            f32x16 O[2];
            flash<64, true>(O, PQK + qrow * 2048 + 1024 + hf * 64, PQK + (size_t)b * LT * 2048 + 1536 + hf * 64, vt, ntiles, q, 0.f,
                            (const float*)(p.ws + OFF_CUMF) + (size_t)(b * 8 + hf) * LP, sqrtf(__uint_as_float(knm[b * 16 + 8 + hf])), smem);
            if (q < LT) {
                bf16_t* d = MIX + qrow * 1024 + 512 + hf * 64;
#pragma unroll
                for (int dt = 0; dt < 2; ++dt)
#pragma unroll
                    for (int g = 0; g < 4; ++g) {
                        const int dv = dt * 32 + 8 * g + 4 * h;
                        u32x2 wv; wv[0] = cvt_pk(O[dt][4 * g], O[dt][4 * g + 1]); wv[1] = cvt_pk(O[dt][4 * g + 2], O[dt][4 * g + 3]);
                        *(u32x2*)(d + dv) = wv;
                    }
            }
        }
    }
}

DI void ph_ln(const Params& p, int lnidx, bool last) {
    const int lane = opaque_tid() & 63;
    const int gw = blockIdx.x * 8 + (opaque_tid() >> 6), nw = gridDim.x * 8;
    float* H = (float*)(p.ws + OFF_H); bf16_t* HB = (bf16_t*)(p.ws + OFF_HB);
    const float* G = p.ln_g + (size_t)lnidx * 1024; const float* Bv = p.ln_b + (size_t)lnidx * 1024;
    f32x4 g[4], bb[4];
#pragma unroll
    for (int i = 0; i < 4; ++i) { g[i] = *(const f32x4*)(G + i * 256 + lane * 4); bb[i] = *(const f32x4*)(Bv + i * 256 + lane * 4); }
    f32x4 nv[4];
    if (gw < MT) {
#pragma unroll
        for (int i = 0; i < 4; ++i) nv[i] = *(const f32x4*)(H + (size_t)gw * 1024 + i * 256 + lane * 4);
    }
    for (int m = gw; m < MT; m += nw) {
        f32x4 v[4];
#pragma unroll
        for (int i = 0; i < 4; ++i) v[i] = nv[i];
        const int mn = min(m + nw, MT - 1);
#pragma unroll
        for (int i = 0; i < 4; ++i) nv[i] = *(const f32x4*)(H + (size_t)mn * 1024 + i * 256 + lane * 4);
        float s = 0.f;
#pragma unroll
        for (int i = 0; i < 4; ++i) s += (v[i][0] + v[i][1]) + (v[i][2] + v[i][3]);
        for (int o = 32; o > 0; o >>= 1) s += __shfl_xor(s, o);
        const float mu = s * (1.0f / 1024.0f);
        float qv = 0.f;
#pragma unroll
        for (int i = 0; i < 4; ++i)
#pragma unroll
            for (int e = 0; e < 4; ++e) { const float d = v[i][e] - mu; qv += d * d; }
        for (int o = 32; o > 0; o >>= 1) qv += __shfl_xor(qv, o);
        const float rstd = __frsqrt_rn(qv * (1.0f / 1024.0f) + 1e-5f);
        const int b = m / LT, pos = m - b * LT;
#pragma unroll
        for (int i = 0; i < 4; ++i) {
            const int c = i * 256 + lane * 4;
            f32x4 y;
#pragma unroll
            for (int e = 0; e < 4; ++e) y[e] = (v[i][e] - mu) * rstd * g[i][e] + bb[i][e];
            if (last) {
                if (pos >= 16) *(f32x4*)(p.out + ((size_t)b * 8192 + (pos - 16)) * 1024 + c) = y;
            } else {
                u32x2 wv; wv[0] = cvt_pk(y[0], y[1]); wv[1] = cvt_pk(y[2], y[3]);
                *(u32x2*)(HB + (size_t)m * 1024 + c) = wv;
            }
        }
        if (!last && lane == 0) ((f32x2*)((unsigned char*)p.out + OFFO_STATS))[m] = (f32x2){mu, rstd};
    }
}

DI void ph_zero_ret_pads(const Params& p) {
    const int tid = opaque_tid();
    for (int idx = blockIdx.x * NT + tid; idx < (128 + 256) * 3 * 64; idx += gridDim.x * NT) {
        const int ch16 = idx & 63, blk = idx >> 6, s_ = blk % 3, g = blk / 3;
        bf16_t* base = g < 128 ? (bf16_t*)(p.ws + OFF_KHATT) + (size_t)(g * 4 + s_) * 512 : (bf16_t*)(p.ws + OFF_VT1) + (size_t)((g - 128) * 4 + s_) * 512;
        *(u32x4*)(base + ch16 * 8) = (u32x4){0u, 0u, 0u, 0u};
    }
}

DI void ph_sprep(const Params& p) {
    const int tid = opaque_tid(), lane = tid & 63, w = tid >> 6, r = lane & 31, h = lane >> 5;
    const int it_ = (w >> 1) & 1, jt = w & 1;
    const bf16_t* QH = (const bf16_t*)((unsigned char*)p.out + OFFO_QHAT);
    const bf16_t* KH = (const bf16_t*)(p.ws + OFF_KHAT);
    bf16_t* SB = (bf16_t*)((unsigned char*)p.out + OFFO_SBUF);
    for (int item = blockIdx.x * 2 + (w >> 2); item < NCH * 16; item += gridDim.x * 2) {
        const int c = item >> 4, b = (item >> 2) & 3, hd = item & 3;
        const int ppi = c * 64 + it_ * 32 + r, ppj = c * 64 + jt * 32 + r;
        const bool vi = ppi >= 48, vj = ppj >= 48;
        const bf16_t* qp = QH + (size_t)item * 16384 + (size_t)it_ * 512 + lane * 8;
        const bf16_t* kp = KH + ((size_t)b * LT + (vj ? ppj - 48 : 0)) * 1024 + hd * 256 + h * 8;
        f32x16 acc = zero16();
        const bf16x8 z8 = {0, 0, 0, 0, 0, 0, 0, 0};
#pragma unroll 8
        for (int s = 0; s < 16; ++s) {
            bf16x8 a = *(const bf16x8*)(qp + ((s >> 1) * 4 + (s & 1) * 2) * 512), bq = *(const bf16x8*)(kp + s * 16);
            if (!vi) a = z8;
            if (!vj) bq = z8;
            acc = mfma32(a, bq, acc);
        }
        const float lg = log2f(1.f - ex2(-5.f - (float)hd));
        const int j = jt * 32 + r;
#pragma unroll
        for (int reg = 0; reg < 16; ++reg) {
            const int i = it_ * 32 + crow(reg, h);
            const int e = (i >= j) ? -64 : 2 * (j - i) - 64;
            SB[sf_off(item, i, j)] = f2bf(acc[reg] * ex2(lg * (float)e));
        }
    }
}

DI void scan_block(const Params& p, const int u) {
    const int tid = opaque_tid(), lane = tid & 63, r = lane & 31, h = lane >> 5;
    const int w = __builtin_amdgcn_readfirstlane(tid >> 6);
    const int sl = u & 15, hd = (u >> 4) & 3, b = u >> 6;
    const float lg = log2f(1.f - ex2(-5.f - (float)hd));
    const float cdec = ex2(lg * 64.f);
    const int it0 = b * 4 + hd;
    constexpr size_t KSTEP = (size_t)16 * 8 * 4 * 512, VSTEP = (size_t)16 * 16 * 4 * 512, SSTEP = (size_t)16 * 8 * 512;
    const bf16_t* KF = (const bf16_t*)(p.ws + OFF_KHATT) + (size_t)(it0 * 8 + w) * 4 * 512 + lane * 8;
    const bf16_t* VG = (const bf16_t*)(p.ws + OFF_VT1) + (size_t)(it0 * 16 + sl) * 4 * 512 + (w & 3) * 512 + lane * 8;
    bf16_t* OB = (bf16_t*)(p.ws + OFF_VT1) + (size_t)(it0 * 16 + sl) * 4 * 512;
    const bf16_t* QF = (const bf16_t*)((unsigned char*)p.out + OFFO_QHAT) + (size_t)(it0 * 8 + w) * 4 * 512 + lane * 8;
    const bf16_t* SF = (const bf16_t*)((unsigned char*)p.out + OFFO_SBUF) + (size_t)it0 * 8 * 512 + ((w >> 2) * 4 + (w & 3)) * 512 + lane * 8;
    float* PART = (float*)((unsigned char*)p.out + OFFO_PART);
    f32x4* red = (f32x4*)dsm;
    bf16_t* vlds = (bf16_t*)(dsm + SMEM_BYTES + 4096);
    const bf16x8 z8 = {0, 0, 0, 0, 0, 0, 0, 0};
    const bool ok0 = r >= 48 - 0, ok1 = false;
    (void)ok0; (void)ok1;

    f32x16 st = zero16();
    bf16x8 kaA[4], qA[2][2], sA, kaB[4], qB[2][2], sB, kaC[4], qC[2][2], sC;
    bf16x8 vg = z8, vg2 = z8;
#define LOADSET(KA_, Q_, S_, c_) do { const int cc_ = min((c_), NCH - 1); \
        _Pragma("unroll") for (int s_ = 0; s_ < 4; ++s_) KA_[s_] = *(const bf16x8*)(KF + cc_ * KSTEP + s_ * 512); \
        _Pragma("unroll") for (int it_ = 0; it_ < 2; ++it_) { \
            Q_[it_][0] = *(const bf16x8*)(QF + cc_ * KSTEP + (0 * 2 + it_) * 512); Q_[it_][1] = *(const bf16x8*)(QF + cc_ * KSTEP + (1 * 2 + it_) * 512); \
            if (cc_ * 64 + it_ * 32 + r < 48) { Q_[it_][0] = z8; Q_[it_][1] = z8; } } \
        S_ = *(const bf16x8*)(SF + cc_ * SSTEP); } while (0)
#define SCAN_STEP(c_, KA_, Q_, S_, KL_, QL_, SL_) do { const int c = (c_); \
        if (w < 4) { *(bf16x8*)(vlds + (((c + 1) & 1) * 4 + w) * 512 + lane * 8) = vg; vg = vg2; vg2 = *(const bf16x8*)(VG + (size_t)min(c + 3, NCH - 1) * VSTEP); } \
        LOADSET(KL_, QL_, SL_, c + 2); \
        bf16x8 vf[4]; \
        _Pragma("unroll") for (int s_ = 0; s_ < 4; ++s_) vf[s_] = *(const bf16x8*)(vlds + ((c & 1) * 4 + s_) * 512 + lane * 8); \
        const bf16x8 vw = *(const bf16x8*)(vlds + ((c & 1) * 4 + (w & 3)) * 512 + lane * 8); \
        f32x16 o0 = zero16(), o1 = zero16(); \
        if (w < 4) o0 = mfma32(vw, S_, o0); else o1 = mfma32(vw, S_, o1); \
        { const bf16x8 a0 = pack8<0>(st), a1 = pack8<1>(st); \
          o0 = mfma32(a0, Q_[0][0], o0); o1 = mfma32(a0, Q_[1][0], o1); o0 = mfma32(a1, Q_[0][1], o0); o1 = mfma32(a1, Q_[1][1], o1); } \
        _Pragma("unroll") for (int i = 0; i < 16; ++i) st[i] *= cdec; \
        _Pragma("unroll") for (int s_ = 0; s_ < 4; ++s_) st = mfma32(KA_[s_], vf[s_], st); \
        f32x4* rb = red + (size_t)(((c & 1) * 8 + w) * 8) * 64 + lane; \
        _Pragma("unroll") for (int g = 0; g < 4; ++g) { \
            rb[(0 * 4 + g) * 64] = (f32x4){o0[4 * g], o0[4 * g + 1], o0[4 * g + 2], o0[4 * g + 3]}; \
            rb[(1 * 4 + g) * 64] = (f32x4){o1[4 * g], o1[4 * g + 1], o1[4 * g + 2], o1[4 * g + 3]}; } \
        __syncthreads(); \
        { const int it2 = w >> 2, g2 = w & 3; \
          const f32x4* rr = red + (size_t)((c & 1) * 8 * 8 + it2 * 4 + g2) * 64 + lane; \
          f32x4 a = rr[0]; \
          _Pragma("unroll") for (int wv = 1; wv < 8; ++wv) { const f32x4 t = rr[(size_t)wv * 8 * 64]; a[0] += t[0]; a[1] += t[1]; a[2] += t[2]; a[3] += t[3]; } \
          const int pp = c * 64 + it2 * 32 + r; \
          float ss = (a[0] * a[0] + a[1] * a[1]) + (a[2] * a[2] + a[3] * a[3]); \
          ss = xsum32(ss); \
          const int i_ = it2 * 32 + r; \
          bf16_t* od = OB + c * VSTEP + (size_t)((i_ >> 4) * 64 + ((i_ >> 3) & 1) * 32 + 8 * g2 + 4 * h) * 8 + (i_ & 7); \
          od[0] = f2bf(a[0]); od[8] = f2bf(a[1]); od[16] = f2bf(a[2]); od[24] = f2bf(a[3]); \
          if (h == 0 && pp >= 48) PART[((size_t)b * LT + pp - 48) * 256 + hd * 64 + sl * 4 + g2] = ss; } } while (0)

    if (w < 4) { const bf16x8 v0 = *(const bf16x8*)(VG); *(bf16x8*)(vlds + w * 512 + lane * 8) = v0; vg = *(const bf16x8*)(VG + VSTEP); vg2 = *(const bf16x8*)(VG + 2 * VSTEP); }
    LOADSET(kaA, qA, sA, 0);
    LOADSET(kaB, qB, sB, 1);
    __syncthreads();
    for (int c3 = 0; c3 < NCH; c3 += 3) {
        SCAN_STEP(c3, kaA, qA, sA, kaC, qC, sC);
        SCAN_STEP(c3 + 1, kaB, qB, sB, kaA, qA, sA);
        SCAN_STEP(c3 + 2, kaC, qC, sC, kaB, qB, sB);
    }
#undef LOADSET
#undef SCAN_STEP
    __syncthreads();
}

DI void ph_scan(const Params& p) {
    for (int ub = blockIdx.x; ub < 256; ub += gridDim.x) {
        const int xcd = ub & 7, j = ub >> 3;
        scan_block(p, ((xcd * 2 + (j >> 4)) << 4) | (j & 15));
    }
}

constexpr int NPHASE = 18;
template <int ph>
DI void run_phase(const Params& p, bf16_t* smem, float* s_aux) {
    const bf16_t* HB = (const bf16_t*)(p.ws + OFF_HB);
    switch (ph) {
        case 0: ph_prologue(p, smem); ph_fb(p); break;
        case 1: ph_gemm<EPI_E1, 1024>(p, HB, (const bf16_t*)(p.ws + OFF_W0IN), 3072, s_aux); break;
        case 2: ph_cumsum(p, smem); ph_knorm(p); break;
        case 3: ph_attn(p, smem, (int*)(s_aux + 256)); break;
        case 4: ph_gemm<EPI_RESID, 1024>(p, HB, (const bf16_t*)(p.ws + OFF_W0OUT), 1024, s_aux); break;
        case 5: ph_ln(p, 0, false); break;
        case 6: ph_gemm<EPI_FFN1, 1024>(p, HB, (const bf16_t*)(p.ws + OFF_F1), 4096, s_aux); break;
        case 7: ph_gemm<EPI_RESID, 4096, 0>(p, (const bf16_t*)(p.ws + OFF_U), (const bf16_t*)(p.ws + OFF_F2), 1024, s_aux); break;
        case 8: ph_ln(p, 1, false); break;
        case 9: ph_zero_ret_pads(p); ph_gemm<EPI_E5, 1024>(p, HB, (const bf16_t*)(p.ws + OFF_W1IN), 4096, s_aux); break;
        case 10: ph_sprep(p); break;
        case 11: ph_scan(p); break;
        case 12: ph_gemm<EPI_E5B, 1024>(p, HB, (const bf16_t*)(p.ws + OFF_W1IN) + (size_t)4096 * 1024, 2048, s_aux); break;
        case 13: ph_gemm<EPI_RESID, 2048, 1>(p, (const bf16_t*)(p.ws + OFF_YB), (const bf16_t*)(p.ws + OFF_W1OUT), 1024, s_aux); break;
        case 14: ph_ln(p, 2, false); break;
        case 15: ph_gemm<EPI_FFN1, 1024>(p, HB, (const bf16_t*)(p.ws + OFF_F1 + SZ_F), 4096, s_aux); break;
        case 16: ph_gemm<EPI_RESID, 4096, 2>(p, (const bf16_t*)(p.ws + OFF_U), (const bf16_t*)(p.ws + OFF_F2 + SZ_F), 1024, s_aux); break;
        case 17: ph_ln(p, 3, true); break;
    }
}

__global__ void __launch_bounds__(512, 2) k_mega(Params p) {
    bf16_t* smem = (bf16_t*)dsm;
    float* s_aux = (float*)(dsm + SMEM_BYTES);
    uint4* xbw = (uint4*)(dsm + SMEM_BYTES + 1536);
    cg::grid_group grid = cg::this_grid();
    if (opaque_tid() == 0) *xbw = make_uint4(0u, 0u, 0u, 0u);
    __syncthreads();
    const XcdBarrier xb = xcd_barrier_post((unsigned*)(p.ws + OFF_BAR), (volatile LAS unsigned*)xbw);
    if (p.ws == nullptr) grid.sync();
#define PHS(N) run_phase<N>(p, smem, s_aux); xcd_barrier(xb);
    PHS(0) PHS(1) PHS(2) PHS(3) PHS(4) PHS(5) PHS(6) PHS(7) PHS(8) PHS(9) PHS(10) PHS(11) PHS(12) PHS(13) PHS(14) PHS(15) PHS(16)
    run_phase<17>(p, smem, s_aux);
}

extern "C" void kernel_launch(void* const* d_in, const int* in_sizes, int n_in, void* d_out, int out_size, void* d_ws, size_t ws_size, hipStream_t stream) {
    Params p{};
    p.x = (const float*)d_in[0]; p.meta = (const float*)d_in[1]; p.ew_in = (const float*)d_in[2]; p.ef_bias = (const float*)d_in[3];
    p.dlam = (const float*)d_in[4]; p.subln = (const float*)d_in[5]; p.ew_out = (const float*)d_in[6]; p.rw_in = (const float*)d_in[7];
    p.rw_out = (const float*)d_in[8]; p.ln_g = (const float*)d_in[9]; p.ln_b = (const float*)d_in[10]; p.f_w1 = (const float*)d_in[11];
    p.f_w2 = (const float*)d_in[12]; p.out = (float*)d_out; p.ws = (unsigned char*)d_ws;
    if (ws_size < WS_END) { fprintf(stderr, "workspace too small: %zu < %zu\n", ws_size, (size_t)WS_END); }
    static int grid_blocks = 0;
    if (!grid_blocks) {
        int dev = 0, cus = 0, per_cu = 0;
        hipGetDevice(&dev);
        hipDeviceGetAttribute(&cus, hipDeviceAttributeMultiprocessorCount, dev);
        (void)hipFuncSetAttribute((const void*)k_mega, hipFuncAttributeMaxDynamicSharedMemorySize, DSM_BYTES);
        (void)hipOccupancyMaxActiveBlocksPerMultiprocessor(&per_cu, k_mega, NT, DSM_BYTES);
        if (per_cu < 1) fprintf(stderr, "occupancy query returned %d\n", per_cu);
        grid_blocks = cus;
    }
    void* args[] = {&p};
    (void)hipMemsetAsync((unsigned char*)d_ws + OFF_BAR, 0, 16384 + 4096, stream);
    hipError_t e = hipLaunchCooperativeKernel((void*)k_mega, dim3(grid_blocks), dim3(NT), args, DSM_BYTES, stream);
    if (e != hipSuccess) fprintf(stderr, "cooperative launch failed: %s (grid %d)\n", hipGetErrorString(e), grid_blocks);
}
```

```cpp
#include <hip/hip_runtime.h>
#include <hip/hip_cooperative_groups.h>
#include <cstdio>
#include <cstdint>
namespace cg = cooperative_groups;

#ifndef MEGA
#define MEGA 1
#endif

#define DI __device__ __forceinline__
typedef unsigned short bf16_t;
typedef __attribute__((ext_vector_type(8))) short bf16x8;
typedef __attribute__((ext_vector_type(16))) float f32x16;
typedef __attribute__((ext_vector_type(4))) float f32x4;
typedef __attribute__((ext_vector_type(2))) float f32x2;
typedef __attribute__((ext_vector_type(2))) __bf16 bf16x2v;
typedef __attribute__((ext_vector_type(4))) unsigned u32x4;
typedef __attribute__((ext_vector_type(2))) unsigned u32x2;

constexpr int BATCH = 4, LT = 8208, MT = BATCH * LT  , LP = 8320, LR = 8256, DM = 1024;
constexpr int NTM = (MT + 127) / 128;
constexpr int NCH = 129;
constexpr float LOG2E = 1.4426950408889634f;
constexpr float ALPHA = 1.4142135623730951f;

constexpr size_t SZ_W0IN = 3072ull * 1024 * 2, SZ_W0OUT = 1024ull * 1024 * 2, SZ_W1IN = 6144ull * 1024 * 2, SZ_W1OUT = 1024ull * 2048 * 2, SZ_F = 4096ull * 1024 * 2;
constexpr size_t OFF_W0IN = 0;
constexpr size_t OFF_W0OUT = OFF_W0IN + SZ_W0IN;
constexpr size_t OFF_W1IN = OFF_W0OUT + SZ_W0OUT;
constexpr size_t OFF_W1OUT = OFF_W1IN + SZ_W1IN;
constexpr size_t OFF_F1 = OFF_W1OUT + SZ_W1OUT;
constexpr size_t OFF_F2 = OFF_F1 + 2 * SZ_F;
constexpr size_t OFF_H = OFF_F2 + 2 * SZ_F;
constexpr size_t OFF_HB = OFF_H + (size_t)MT * 1024 * 4;
constexpr size_t OFF_LOGF = OFF_HB + (size_t)MT * 1024 * 2;
constexpr size_t OFF_CUMF = OFF_LOGF + (size_t)BATCH * 8 * LP * 4;
constexpr size_t OFF_MISC = OFF_CUMF + (size_t)BATCH * 8 * LP * 4;
constexpr size_t OFF_BAR = OFF_MISC + 4096;
constexpr size_t OFF_CNT = OFF_BAR + 16384;
constexpr size_t OFF_R = OFF_MISC + 32768;
constexpr size_t OFF_PQK = OFF_R;
constexpr size_t OFF_VTA = OFF_PQK + (size_t)MT * 2048 * 2;
constexpr size_t OFF_VTB = OFF_VTA + (size_t)BATCH * 512 * LP * 2;
constexpr size_t OFF_U = OFF_R;
constexpr size_t OFF_KHAT = OFF_R;
constexpr size_t OFF_KHATT = OFF_KHAT + (size_t)MT * 1024 * 2;
constexpr size_t OFF_VT1 = OFF_KHATT + (size_t)BATCH * 1024 * LR * 2;
constexpr size_t OFF_YB = OFF_KHAT;
constexpr size_t WS_END = OFF_VT1 + (size_t)BATCH * 2048 * LR * 2;
static_assert(OFF_U + (size_t)MT * 4096 * 2 <= WS_END + 4000000, "ws");
static_assert(WS_END <= 536870912ull, "ws too big");
static_assert((size_t)MT * 2048 * 2 <= (OFF_VT1 - OFF_KHAT), "yb alias");
constexpr size_t OFFO_QHAT = 0;
constexpr size_t OFFO_SBUF = OFFO_QHAT + (size_t)NCH * 16 * 64 * 256 * 2;
constexpr size_t OFFO_PART = OFFO_SBUF + (size_t)NCH * 16 * 4096 * 2;
constexpr size_t OFFO_DUMMY = OFFO_PART + (size_t)MT * 256 * 4;
static_assert(OFFO_DUMMY + 256 * 512 * 4 <= 124ull * 1048576, "out scratch");
constexpr size_t OFFO_STATS = 124ull * 1048576;
static_assert(OFFO_STATS + (size_t)MT * 8 <= 134217728ull, "out scratch");

struct Params {
    const float *x, *meta, *ew_in, *ef_bias, *dlam, *subln, *ew_out, *rw_in, *rw_out, *ln_g, *ln_b, *f_w1, *f_w2;
    float* out;
    unsigned char* ws;
};

DI unsigned cvt_pk(float lo, float hi) { f32x2 v = {lo, hi}; bf16x2v b = __builtin_convertvector(v, bf16x2v); return __builtin_bit_cast(unsigned, b); }
DI bf16_t f2bf(float x) { return (bf16_t)(cvt_pk(x, 0.f) & 0xffffu); }
DI f32x16 mfma32(bf16x8 a, bf16x8 b, f32x16 c) { return __builtin_amdgcn_mfma_f32_32x32x16_bf16(a, b, c, 0, 0, 0); }
DI int crow(int reg, int h) { return (reg & 3) + 8 * (reg >> 2) + 4 * h; }
DI int perm23(int r) { return (r & 0x13) | ((r & 4) << 1) | ((r & 8) >> 1); }
template <int S> DI bf16x8 pack8(const f32x16& x) {
    u32x4 p;
    p[0] = cvt_pk(x[8 * S + 0], x[8 * S + 1]); p[1] = cvt_pk(x[8 * S + 2], x[8 * S + 3]);
    p[2] = cvt_pk(x[8 * S + 4], x[8 * S + 5]); p[3] = cvt_pk(x[8 * S + 6], x[8 * S + 7]);
    return __builtin_bit_cast(bf16x8, p);
}
DI f32x16 zero16() { f32x16 z; for (int i = 0; i < 16; ++i) z[i] = 0.f; return z; }
DI float ex2(float x) { return __builtin_amdgcn_exp2f(x); }
DI float xsum32(float x) { auto r = __builtin_amdgcn_permlane32_swap(__float_as_uint(x), __float_as_uint(x), false, false); return __uint_as_float(r[0]) + __uint_as_float(r[1]); }
DI float xmax32(float x) { auto r = __builtin_amdgcn_permlane32_swap(__float_as_uint(x), __float_as_uint(x), false, false); return fmaxf(__uint_as_float(r[0]), __uint_as_float(r[1])); }
DI int opaque_tid() { int t = threadIdx.x; asm volatile("" : "+v"(t)); return t; }


#define XB_TMO      128
#define XB_XCNT(j)  (256  + 64 * (j))
#define XB_XSUB(j)  (1280 + 64 * (j))
#define XB_XGEN(j)  (2304 + 64 * (j))
#define XB_TOP      3328
#define XB_TOPGEN   3392
#define XCD_BAR_WORDS 3456
#define XB_SPIN_CAP (1u << 20)
#define LAS __attribute__((address_space(3)))
DI unsigned xb_ld(unsigned* p) { return __hip_atomic_load(p, __ATOMIC_RELAXED, __HIP_MEMORY_SCOPE_AGENT); }
DI unsigned xb_add(unsigned* p, unsigned v) { return __hip_atomic_fetch_add(p, v, __ATOMIC_RELAXED, __HIP_MEMORY_SCOPE_AGENT); }
DI unsigned xb_xcc_id() { return (unsigned)__builtin_amdgcn_s_getreg((3 << 11) | 20) & 0xFu; }
#define XB_SPIN(cond, bar) do { unsigned _sp = 0; while (cond) { __builtin_amdgcn_s_sleep(1); \
    if ((++_sp & 255u) == 0u) { if (xb_ld(&(bar)[XB_TMO])) break; if (_sp > XB_SPIN_CAP) { atomicAdd(&(bar)[XB_TMO], 1u); break; } } } } while (0)
struct XcdBarrier { unsigned* bar; unsigned x; volatile LAS unsigned* st; };
DI XcdBarrier xcd_barrier_post(unsigned* bar, volatile LAS unsigned* st) {
    XcdBarrier b; b.bar = bar; b.x = xb_xcc_id(); b.st = st;
    if (opaque_tid() == 0) (void)xb_add(&bar[XB_XCNT(b.x)], 1u);
    return b;
}
DI void xcd_barrier_complete(unsigned* bar, unsigned x, unsigned& nloc, unsigned& nx) {
    const unsigned G = gridDim.x * gridDim.y * gridDim.z;
    unsigned sum, cnt, mine, sp = 0u;
    for (;;) {
        sum = 0u; cnt = 0u; mine = 0u;
#pragma unroll
        for (unsigned j = 0; j < 16; ++j) { const unsigned c = xb_ld(&bar[XB_XCNT(j)]); sum += c; cnt += (c > 0u) ? 1u : 0u; mine = (j == x) ? c : mine; }
        if (sum == G) break;
        __builtin_amdgcn_s_sleep(1);
        if ((++sp & 255u) == 0u) { if (xb_ld(&bar[XB_TMO])) break; if (sp > XB_SPIN_CAP) { atomicAdd(&bar[XB_TMO], 1u); break; } }
    }
    nloc = mine > 0u ? mine : 1u; nx = cnt > 0u ? cnt : 1u;
}
DI void xcd_barrier(const XcdBarrier& b) {
    asm volatile("s_waitcnt vmcnt(0)" ::: "memory");
    __syncthreads();
    if (opaque_tid() == 0) {
        unsigned* bar = b.bar;
        __builtin_amdgcn_s_waitcnt(0);
        unsigned nloc = b.st[0], nx = b.st[1];
        if (nloc == 0u) { xcd_barrier_complete(bar, b.x, nloc, nx); b.st[0] = nloc; b.st[1] = nx; }
        const unsigned old = xb_add(&bar[XB_XSUB(b.x)], 1u);
        const unsigned gen = old / nloc;
        if (old + 1u == (gen + 1u) * nloc) {
            __builtin_amdgcn_fence(__ATOMIC_RELEASE, "agent");
            asm volatile("s_waitcnt vmcnt(0)" ::: "memory");
            const unsigned og = xb_add(&bar[XB_TOP], 1u);
            const unsigned tg = og / nx;
            if (og + 1u == (tg + 1u) * nx) xb_add(&bar[XB_TOPGEN], 1u);
            else XB_SPIN(xb_ld(&bar[XB_TOPGEN]) == tg, bar);
            __builtin_amdgcn_fence(__ATOMIC_ACQUIRE, "agent");
            xb_add(&bar[XB_XGEN(b.x)], 1u);
            asm volatile("s_waitcnt vmcnt(0)" ::: "memory");
        } else {
            XB_SPIN(xb_ld(&bar[XB_XGEN(b.x)]) == gen, bar);
            __builtin_amdgcn_fence(__ATOMIC_ACQUIRE, "agent");
            asm volatile("s_waitcnt vmcnt(0)" ::: "memory");
        }
    }
    __syncthreads();
}


DI size_t qf_off(int item, int i, int dk) { return ((size_t)(((item * 8 + (dk >> 5)) * 2 + ((dk >> 4) & 1)) * 2 + (i >> 5)) * 64 + ((dk >> 3) & 1) * 32 + (i & 31)) * 8 + (dk & 7); }
DI size_t kf_off(int item, int dk, int j) { return ((size_t)((item * 8 + (dk >> 5)) * 4 + (j >> 4)) * 64 + ((j >> 3) & 1) * 32 + perm23(dk & 31)) * 8 + (j & 7); }
DI size_t vf_off(int item, int dvh, int j) { return ((size_t)((item * 16 + (dvh >> 5)) * 4 + (j >> 4)) * 64 + ((j >> 3) & 1) * 32 + (dvh & 31)) * 8 + (j & 7); }
DI size_t sf_off(int item, int i, int j) { return ((size_t)((item * 2 + (i >> 5)) * 4 + (j >> 4)) * 64 + ((j >> 3) & 1) * 32 + (i & 31)) * 8 + (j & 7); }

constexpr int NT = 512;
constexpr int SMEM_BYTES = 131072;
constexpr int DSM_BYTES = SMEM_BYTES + 4096 + 8192;
extern __shared__ __attribute__((aligned(16))) unsigned char dsm[];

DI void transpose_tile(const float* __restrict__ src, int ld, bf16_t* __restrict__ dst, int K, int k0, int n0, float* tile) {
    const int tid = opaque_tid();
#pragma unroll 4
    for (int i = 0; i < 8; ++i) { const int k = (tid >> 6) + 8 * i, n = tid & 63; tile[k * 65 + n] = src[(size_t)(k0 + k) * ld + n0 + n]; }
    __syncthreads();
#pragma unroll 4
    for (int i = 0; i < 8; ++i) { const int n = (tid >> 6) + 8 * i, k = tid & 63; dst[(size_t)(n0 + n) * K + k0 + k] = f2bf(tile[k * 65 + n]); }
    __syncthreads();
}

DI void ph_prologue(const Params& p, bf16_t* smem) {
    float* tile = (float*)smem;
    const int tid = opaque_tid();
    auto decode = [&](int it, const float*& sp, bf16_t*& dp, int& ld, int& K) {
        const float* src; int N; bf16_t* dst; int t = it;
        if (t < 768) { src = p.ew_in; ld = 3080; K = 1024; N = 3072; dst = (bf16_t*)(p.ws + OFF_W0IN); }
        else if ((t -= 768) < 256) { src = p.ew_out; ld = 1024; K = 1024; N = 1024; dst = (bf16_t*)(p.ws + OFF_W0OUT); }
        else if ((t -= 256) < 1536) { src = p.rw_in; ld = 6144; K = 1024; N = 6144; dst = (bf16_t*)(p.ws + OFF_W1IN); }
        else if ((t -= 1536) < 512) { src = p.rw_out; ld = 1024; K = 2048; N = 1024; dst = (bf16_t*)(p.ws + OFF_W1OUT); }
        else if ((t -= 512) < 2048) { const int l = t >> 10; t &= 1023; src = p.f_w1 + (size_t)l * 1024 * 4096; ld = 4096; K = 1024; N = 4096; dst = (bf16_t*)(p.ws + OFF_F1 + l * SZ_F); }
        else { t -= 2048; const int l = t >> 10; t &= 1023; src = p.f_w2 + (size_t)l * 4096 * 1024; ld = 1024; K = 4096; N = 1024; dst = (bf16_t*)(p.ws + OFF_F2 + l * SZ_F); }
        const int ntn = N >> 6, k0 = (t / ntn) * 64, n0 = (t % ntn) * 64;
        sp = src + (size_t)k0 * ld + n0;
        dp = dst + (size_t)n0 * K + k0;
    };
    {
        const int tr = tid >> 6, tc = tid & 63;
        int it = blockIdx.x;
        const float* sp = nullptr; bf16_t* dp = nullptr; int ld = 0, K = 0;
        float pre[8];
        if (it < 7168) {
            decode(it, sp, dp, ld, K);
#pragma unroll
            for (int i = 0; i < 8; ++i) pre[i] = sp[(size_t)(tr + 8 * i) * ld + tc];
        }
        while (it < 7168) {
#pragma unroll
            for (int i = 0; i < 8; ++i) tile[(tr + 8 * i) * 65 + tc] = pre[i];
            __syncthreads();
            bf16_t* dcur = dp; const int Kcur = K;
            const int itn = it + (int)gridDim.x;
            if (itn < 7168) {
                decode(itn, sp, dp, ld, K);
#pragma unroll
                for (int i = 0; i < 8; ++i) pre[i] = sp[(size_t)(tr + 8 * i) * ld + tc];
            }
#pragma unroll
            for (int i = 0; i < 8; ++i) dcur[(size_t)(tr + 8 * i) * Kcur + tc] = f2bf(tile[tc * 65 + tr + 8 * i]);
            __syncthreads();
            it = itn;
        }
    }
    bf16_t* VT = (bf16_t*)(p.ws + OFF_VTA);
    for (int idx = blockIdx.x * NT + tid; idx < 4096 * 6; idx += gridDim.x * NT) {
        const int row = idx / 6, c = idx % 6;
        *(u32x4*)(VT + ((size_t)128 * 4096 + row) * 64 + 16 + c * 8) = (u32x4){0u, 0u, 0u, 0u};
    }
    if (blockIdx.x == 0 && tid < 64) {
        float a = p.dlam[tid] * p.dlam[64 + tid], b = p.dlam[128 + tid] * p.dlam[192 + tid];
        for (int o = 32; o > 0; o >>= 1) { a += __shfl_xor(a, o); b += __shfl_xor(b, o); }
        if (tid == 0) ((float*)(p.ws + OFF_MISC))[0] = __expf(a) - __expf(b) + 0.2f;
    }
}

enum { EPI_E1 = 0, EPI_RESID = 1, EPI_FFN1 = 2, EPI_E5 = 3, EPI_E5B = 4 };

template <int EPI, int LNI = -1>
DI void epi_store(const Params& p, int row0, int col, int lrow0, float (&v)[4], const float* s_aux, const f32x2* rs = nullptr, float gg = 1.f, float bb = 0.f) {
    const int b = row0 / LT, pos = row0 - b * LT;
    if (EPI == EPI_E1) {
        const int seg = col >> 9, cs = col & 511;
        if (seg == 2 || seg == 5) {
            bf16_t* vt = (bf16_t*)(p.ws + OFF_VTA);
            u32x2 wv; wv[0] = cvt_pk(v[0], v[1]); wv[1] = cvt_pk(v[2], v[3]);
            *(u32x2*)(vt + ((size_t)(pos >> 6) * 4096 + (seg == 2 ? 0 : 2048) + b * 512 + cs) * 64 + (pos & 63)) = wv;
        } else {
            const int oc = (seg == 0 ? 0 : seg == 1 ? 512 : seg == 3 ? 1024 : 1536) + cs;
            bf16_t* d = (bf16_t*)(p.ws + OFF_PQK) + (size_t)row0 * 2048 + oc;
#pragma unroll
            for (int e = 0; e < 4; ++e) d[(size_t)e * 2048] = f2bf(v[e]);
        }
    } else if (EPI == EPI_RESID) {
        float* d = (float*)(p.ws + OFF_H) + (size_t)row0 * 1024 + col;
#pragma unroll
        for (int e = 0; e < 4; ++e) {
            float hprev = d[(size_t)e * 1024];
            if (LNI >= 0) hprev = (hprev - rs[e][0]) * rs[e][1] * gg + bb;
            d[(size_t)e * 1024] = ALPHA * hprev + v[e];
        }
    } else if (EPI == EPI_FFN1) {
        bf16_t* d = (bf16_t*)(p.ws + OFF_U) + (size_t)row0 * 4096 + col;
#pragma unroll
        for (int e = 0; e < 4; ++e) { const float t = fmaxf(v[e], 0.f); d[(size_t)e * 4096] = f2bf(t * t); }
    } else if (EPI == EPI_E5) {
        const int idx = (pos + 48) & 63, ch = (pos + 48) >> 6;
        if (col < 1024) {
            const int hd = col >> 8, item = (ch * 4 + b) * 4 + hd;
            bf16_t* d = (bf16_t*)((unsigned char*)p.out + OFFO_QHAT) + qf_off(item, idx, col & 255);
#pragma unroll
            for (int e = 0; e < 4; ++e) d[e * 8] = f2bf(v[e] * rs[e][0]);
        } else if (col < 2048) {
            const int c = col - 1024, hd = c >> 8, item = (ch * 4 + b) * 4 + hd;
            bf16_t* d = (bf16_t*)(p.ws + OFF_KHAT) + (size_t)row0 * 1024 + c;
#pragma unroll
            for (int e = 0; e < 4; ++e) { v[e] *= rs[e][1]; d[(size_t)e * 1024] = f2bf(v[e]); }
            u32x2 wv; wv[0] = cvt_pk(v[0], v[1]); wv[1] = cvt_pk(v[2], v[3]);
            *(u32x2*)((bf16_t*)(p.ws + OFF_KHATT) + kf_off(item, c & 255, idx)) = wv;
        } else {
            const int c = col - 2048, hd = c >> 9, item = (ch * 4 + b) * 4 + hd;
            u32x2 wv; wv[0] = cvt_pk(v[0], v[1]); wv[1] = cvt_pk(v[2], v[3]);
            *(u32x2*)((bf16_t*)(p.ws + OFF_VT1) + vf_off(item, c & 511, idx)) = wv;
        }
    } else if (EPI == EPI_E5B) {
        const u32x2 ov = *(const u32x2*)((const bf16_t*)(p.ws + OFF_VT1) + vf_off((((pos + 48) >> 6) * 4 + b) * 4 + (col >> 9), col & 511, (pos + 48) & 63));
        bf16_t* d = (bf16_t*)(p.ws + OFF_YB) + (size_t)row0 * 2048 + col;
#pragma unroll
        for (int e = 0; e < 4; ++e) {
            const unsigned ob = (e & 1) ? (ov[e >> 1] & 0xffff0000u) : (ov[e >> 1] << 16);
            const float o = __uint_as_float(ob);
            const float gte = v[e] / (1.f + __expf(-v[e]));
            d[(size_t)e * 2048] = f2bf(gte * o * s_aux[lrow0 + e]);
        }
    }
}

constexpr int G_BK = 64, G_HALF = 128, G_HT = G_HALF * G_BK;
DI int lds_byte(int r, int c) { const int st = (r >> 4) * 2 + (c >> 5), rr = r & 15, cc = c & 31, ob = rr * 64 + cc * 2; return st * 1024 + (ob ^ (((ob >> 9) & 1) << 5)); }
DI void stage_rc(int b, int& R, int& C) { const int st = b / 1024, sb = b % 1024, swz = sb ^ (((sb >> 9) & 1) << 5); R = (st >> 1) * 16 + swz / 64; C = (st & 1) * 32 + (swz % 64) / 2; }

template <int EPI, int K, int LNI>
DI void gemm_tail_unit(const Params& p, const bf16_t* __restrict__ A, const bf16_t* __restrict__ Bt, const int un, float* s_aux) {
    const int tid = opaque_tid(), lane = tid & 63, w = tid >> 6, r = lane & 31, h = lane >> 5;
    constexpr int ROW0 = 32768, KS = K / 8;
    const int col0 = un * 64;
    if (EPI == EPI_E5B) {
        if (tid < 64) {
            const int hd = col0 >> 9;
            const float* pp = (const float*)((unsigned char*)p.out + OFFO_PART) + (size_t)(ROW0 + tid) * 256 + hd * 64;
            float sacc = 0.f;
#pragma unroll
            for (int i = 0; i < 16; ++i) { const f32x4 v = *(const f32x4*)(pp + i * 4); sacc += (v[0] + v[1]) + (v[2] + v[3]); }
            s_aux[tid] = __frsqrt_rn(sacc * (1.0f / 512.0f) + 1e-6f);
        }
    }
    f32x16 acc[2][2];
    acc[0][0] = zero16(); acc[0][1] = zero16(); acc[1][0] = zero16(); acc[1][1] = zero16();
    const bf16_t* ap = A + (size_t)(ROW0 + r) * K + w * KS + h * 8;
    const bf16_t* bp = Bt + (size_t)(col0 + r) * K + w * KS + h * 8;
#pragma unroll 8
    for (int s = 0; s < KS / 16; ++s) {
        const bf16x8 a0 = *(const bf16x8*)(ap + s * 16), a1 = *(const bf16x8*)(ap + (size_t)32 * K + s * 16);
        const bf16x8 b0 = *(const bf16x8*)(bp + s * 16), b1 = *(const bf16x8*)(bp + (size_t)32 * K + s * 16);
        acc[0][0] = mfma32(a0, b0, acc[0][0]); acc[0][1] = mfma32(a0, b1, acc[0][1]);
        acc[1][0] = mfma32(a1, b0, acc[1][0]); acc[1][1] = mfma32(a1, b1, acc[1][1]);
    }
    float* red = (float*)dsm;
#pragma unroll
    for (int i = 0; i < 2; ++i)
#pragma unroll
        for (int j = 0; j < 2; ++j)
#pragma unroll
            for (int reg = 0; reg < 16; ++reg) red[((w * 4 + i * 2 + j) * 16 + reg) * 64 + lane] = acc[i][j][reg];
    __syncthreads();
    {
        const int tile = w >> 1, i = tile >> 1, j = tile & 1;
#pragma unroll
        for (int gg = 0; gg < 2; ++gg) {
            const int g = 2 * (w & 1) + gg;
            float v[4];
#pragma unroll
            for (int e = 0; e < 4; ++e) {
                float sacc = 0.f;
#pragma unroll
                for (int wv = 0; wv < 8; ++wv) sacc += red[((wv * 4 + tile) * 16 + 4 * g + e) * 64 + lane];
                v[e] = sacc;
            }
            const int lrow0 = i * 32 + 8 * g + 4 * h;
            f32x2 rs[4]; float lng = 1.f, lnb = 0.f;
            if (EPI == EPI_E5) {
                lng = log2f(1.f - ex2(-5.f - (float)((col0 >> 8) & 3)));
                const int idx_ = (((ROW0 + lrow0) % LT) + 48) & 63;
#pragma unroll
                for (int e = 0; e < 4; ++e) rs[e] = (f32x2){ex2(lng * (float)(idx_ + e + 1)), 0.0625f * ex2(lng * (float)(63 - idx_ - e))};
            }
            if (EPI == EPI_RESID && LNI >= 0) {
                const f32x2* st_ = (const f32x2*)((unsigned char*)p.out + OFFO_STATS) + ROW0 + lrow0;
#pragma unroll
                for (int e = 0; e < 4; ++e) rs[e] = st_[e];
                lng = p.ln_g[(LNI < 0 ? 0 : LNI) * 1024 + col0 + j * 32 + r]; lnb = p.ln_b[(LNI < 0 ? 0 : LNI) * 1024 + col0 + j * 32 + r];
            }
            epi_store<EPI, LNI>(p, ROW0 + lrow0, col0 + j * 32 + r, lrow0, v, s_aux, rs, lng, lnb);
        }
    }
    __syncthreads();
}

template <int EPI, int K, int LNI = -1>
DI void ph_gemm(const Params& p, const bf16_t* __restrict__ A, const bf16_t* __restrict__ Bt, int N, float* s_aux) {
    constexpr int NXCD = 8, WGM = 8;
    const int nM = 128, nN = N / 256, nwg = nM * nN;
    auto unit = [&](int it, int& pm, int& pn) {
        int wgid = it;
        { const int q = nwg / NXCD, r = nwg % NXCD, xcd = wgid % NXCD, off = wgid / NXCD; wgid = (xcd < r ? xcd * (q + 1) : r * (q + 1) + (xcd - r) * q) + off; }
        const int nig = WGM * nN, gid = wgid / nig, fm = gid * WGM, gsz = min(nM - fm, WGM);
        pm = fm + ((wgid % nig) % gsz); pn = (wgid % nig) / gsz;
    };
    bf16_t* shm = (bf16_t*)dsm;
    typedef __attribute__((address_space(3))) unsigned lds_u32;
    typedef __attribute__((address_space(3))) unsigned char lds_u8;
#define SA(b, h) (shm + ((b) * 2 + (h)) * G_HT)
#define SB(b, h) (shm + (4 + (b) * 2 + (h)) * G_HT)
#define STAGE(P, g) do { const char* g_ = (const char*)(g); \
        __builtin_amdgcn_global_load_lds((const unsigned*)(g_ + so0), (lds_u32*)((lds_u8*)(P) + sb0), 16, 0, 0); \
        __builtin_amdgcn_global_load_lds((const unsigned*)(g_ + so1), (lds_u32*)((lds_u8*)(P) + sb0 + 8192), 16, 0, 0); } while (0)
#define LDA(dst, b, h) for (int m = 0; m < 4; ++m) for (int k = 0; k < 2; ++k) \
        dst[m][k] = *reinterpret_cast<const bf16x8*>((char*)SA(b, h) + lds_byte(wr * 64 + m * 16 + fr, k * 32 + fq * 8))
#define LDB(dst, b, h) for (int n = 0; n < 2; ++n) for (int k = 0; k < 2; ++k) \
        dst[n][k] = *reinterpret_cast<const bf16x8*>((char*)SB(b, h) + lds_byte(wc * 32 + n * 16 + fr, k * 32 + fq * 8))
#define MMA(ai, bj, At_, Bt_) do { __builtin_amdgcn_s_setprio(1); \
        for (int m = 0; m < 4; ++m) for (int n = 0; n < 2; ++n) for (int k = 0; k < 2; ++k) \
            acc[ai][bj][m][n] = __builtin_amdgcn_mfma_f32_16x16x32_bf16(At_[m][k], Bt_[n][k], acc[ai][bj][m][n], 0, 0, 0); \
        __builtin_amdgcn_s_setprio(0); } while (0)
#define WAIT_V(n) asm volatile("s_waitcnt vmcnt(" #n ")" ::: "memory")
#define WAIT_L(n) asm volatile("s_waitcnt lgkmcnt(" #n ")" ::: "memory")
#define BAR __builtin_amdgcn_s_barrier()
#define SCHED __builtin_amdgcn_sched_barrier(0)
    const int wid = opaque_tid() >> 6, lane = opaque_tid() & 63, wr = wid >> 2, wc = wid & 3, fr = lane & 15, fq = lane >> 4;
    const int sb0 = opaque_tid() * 16;
    unsigned so0, so1;
    { int r_, c_; stage_rc(sb0, r_, c_); so0 = (unsigned)(r_ * K + c_) * 2u; stage_rc(sb0 + 8192, r_, c_); so1 = (unsigned)(r_ * K + c_) * 2u; }
    constexpr int nt = K / G_BK;
    constexpr size_t hstep = (size_t)G_HALF * K, kstep = G_BK;

    int it = blockIdx.x, pm, pn;
    unit(it, pm, pn);
    const bf16_t* cA = A + (size_t)pm * 256 * K; const bf16_t* cB = Bt + (size_t)pn * 256 * K;
    STAGE(SB(0, 0), cB); STAGE(SB(0, 1), cB + hstep); STAGE(SA(0, 0), cA); STAGE(SA(0, 1), cA + hstep);
    if (wr == 1) BAR;
    WAIT_V(2); BAR;
    STAGE(SB(1, 0), cB + kstep); STAGE(SA(1, 0), cA + kstep); STAGE(SB(1, 1), cB + hstep + kstep);
    WAIT_V(6); BAR;
    f32x4 acc[2][2][4][2] = {};
    bf16x8 At[4][2], B0[2][2], B1[2][2];
    int cnt = 0;
    for (;;) {
        const int itn = it + (int)gridDim.x;
        const bool has_next = itn < nwg;
        int npm = pm, npn = pn;
        if (has_next) unit(itn, npm, npn);
        const bf16_t* nA = A + (size_t)npm * 256 * K; const bf16_t* nB = Bt + (size_t)npn * 256 * K;
        const int brow = pm * 256, bcol = pn * 256;
        float* sa = s_aux + (cnt & 1) * 512;
        if (EPI == EPI_E5B) {
            if (opaque_tid() < 256) {
                const int row = brow + (int)opaque_tid(); const int hd = bcol >> 9;
                const float* pp = (const float*)((unsigned char*)p.out + OFFO_PART) + (size_t)row * 256 + hd * 64;
                float sacc = 0.f;
#pragma unroll
                for (int i = 0; i < 16; ++i) { const f32x4 v = *(const f32x4*)(pp + i * 4); sacc += (v[0] + v[1]) + (v[2] + v[3]); }
                sa[opaque_tid()] = __frsqrt_rn(sacc * (1.0f / 512.0f) + 1e-6f);
            }
        }
        for (int t = 0; t < nt; t += 2) {
            const bool last = (t == nt - 2);
            const bf16_t* a1 = cA + (size_t)(t + 1) * kstep;
            const bf16_t* a2 = last ? nA : cA + (size_t)(t + 2) * kstep; const bf16_t* b2 = last ? nB : cB + (size_t)(t + 2) * kstep;
            const bf16_t* a3 = a2 + kstep; const bf16_t* b3 = b2 + kstep;
            LDB(B0, 0, 0); LDB(B1, 0, 1); SCHED; LDA(At, 0, 0); STAGE(SA(1, 1), a1 + hstep);
            WAIT_V(8); WAIT_L(0); BAR; MMA(0, 0, At, B0); MMA(0, 1, At, B1); BAR; SCHED;
            LDA(At, 0, 1); STAGE(SB(0, 0), b2); STAGE(SB(0, 1), b2 + hstep); STAGE(SA(0, 0), a2);
            WAIT_V(8); WAIT_L(0); BAR; MMA(1, 0, At, B0); MMA(1, 1, At, B1); BAR; SCHED;
            LDB(B0, 1, 0); LDB(B1, 1, 1); SCHED; LDA(At, 1, 0); STAGE(SA(0, 1), a2 + hstep);
            WAIT_V(8); WAIT_L(0); BAR; MMA(0, 0, At, B0); MMA(0, 1, At, B1); BAR; SCHED;
            LDA(At, 1, 1); STAGE(SB(1, 0), b3); STAGE(SB(1, 1), b3 + hstep); STAGE(SA(1, 0), a3);
            WAIT_V(8); WAIT_L(0); BAR; MMA(1, 0, At, B0); MMA(1, 1, At, B1); BAR; SCHED;
        }
        if (wr == 0) BAR;
        {
            int oz = 0; asm volatile("" : "+v"(oz));
            float lg_[2][2], lb_[2][2];
#pragma unroll
            for (int bj = 0; bj < 2; ++bj)
#pragma unroll
                for (int n = 0; n < 2; ++n) {
                    lg_[bj][n] = 1.f; lb_[bj][n] = 0.f;
                    if (EPI == EPI_E5) lg_[bj][n] = log2f(1.f - ex2(-5.f - (float)((bcol >> 8) & 3)));
                    if (EPI == EPI_RESID && LNI >= 0) { const int c_ = bcol + bj * 128 + wc * 32 + n * 16 + fr; lg_[bj][n] = p.ln_g[(LNI < 0 ? 0 : LNI) * 1024 + c_]; lb_[bj][n] = p.ln_b[(LNI < 0 ? 0 : LNI) * 1024 + c_]; }
                }
#pragma unroll
            for (int ai = 0; ai < 2; ++ai)
#pragma unroll
                for (int m = 0; m < 4; ++m) {
                    const int lrow0 = ai * 128 + wr * 64 + m * 16 + fq * 4, row0 = brow + lrow0 + oz;
                    f32x2 rs[4];
                    if (EPI == EPI_RESID && LNI >= 0) {
                        const f32x2* st_ = (const f32x2*)((unsigned char*)p.out + OFFO_STATS) + row0;
#pragma unroll
                        for (int e = 0; e < 4; ++e) rs[e] = st_[e];
                    }
                    if (EPI == EPI_E5) {
                        const int idx_ = ((row0 % LT) + 48) & 63; const float lgh = lg_[0][0];
#pragma unroll
                        for (int e = 0; e < 4; ++e) rs[e] = (f32x2){ex2(lgh * (float)(idx_ + e + 1)), 0.0625f * ex2(lgh * (float)(63 - idx_ - e))};
                    }
#pragma unroll
                    for (int bj = 0; bj < 2; ++bj)
#pragma unroll
                        for (int n = 0; n < 2; ++n) {
                            float v[4];
#pragma unroll
                            for (int e = 0; e < 4; ++e) v[e] = acc[ai][bj][m][n][e];
                            epi_store<EPI, LNI>(p, row0, bcol + bj * 128 + wc * 32 + n * 16 + fr + oz, lrow0, v, sa, rs, lg_[bj][n], lb_[bj][n]);
                        }
                }
        }
        if (!has_next) break;
#pragma unroll
        for (int a = 0; a < 2; ++a)
#pragma unroll
            for (int b = 0; b < 2; ++b)
#pragma unroll
                for (int m = 0; m < 4; ++m)
#pragma unroll
                    for (int n = 0; n < 2; ++n) acc[a][b][m][n] = (f32x4){0.f, 0.f, 0.f, 0.f};
        pm = npm; pn = npn; cA = nA; cB = nB; it = itn; ++cnt;
        if (wr == 1) BAR;
    }
    WAIT_V(0);
    BAR;
#undef SA
#undef SB
#undef STAGE
#undef LDA
#undef LDB
#undef MMA
    __syncthreads();
    for (int un = blockIdx.x; un < N / 64; un += gridDim.x) gemm_tail_unit<EPI, K, LNI>(p, A, Bt, un, s_aux);
}

DI void ph_fb(const Params& p) {
    const int lane = opaque_tid() & 63;
    const int gw = blockIdx.x * 8 + (opaque_tid() >> 6), nw = gridDim.x * 8;
    float* H = (float*)(p.ws + OFF_H); bf16_t* HB = (bf16_t*)(p.ws + OFF_HB);
    float* LF = (float*)(p.ws + OFF_LOGF);
    f32x4 w0[4][4], w1[4][4];
#pragma unroll
    for (int i = 0; i < 4; ++i)
#pragma unroll
        for (int e = 0; e < 4; ++e) {
            const float* wp = p.ew_in + (size_t)(256 * i + 4 * lane + e) * 3080 + 3072;
            w0[i][e] = *(const f32x4*)wp; w1[i][e] = *(const f32x4*)(wp + 4);
        }
    const int j8 = ((lane >> 5) & 1) * 4 + ((lane >> 4) & 1) * 2 + ((lane >> 3) & 1);
    const float fbias = p.ef_bias[j8];
    for (int m = gw; m < MT; m += nw) {
        const int b_ = m / LT, pos_ = m - b_ * LT;
        const float* hrow = pos_ < 16 ? p.meta + (size_t)pos_ * 1024 : p.x + ((size_t)b_ * 8192 + (pos_ - 16)) * 1024;
        f32x4 hv[4];
#pragma unroll
        for (int i = 0; i < 4; ++i) hv[i] = *(const f32x4*)(hrow + 256 * i + 4 * lane);
#pragma unroll
        for (int i = 0; i < 4; ++i) {
            *(f32x4*)(H + (size_t)m * 1024 + 256 * i + 4 * lane) = hv[i];
            u32x2 wv; wv[0] = cvt_pk(hv[i][0], hv[i][1]); wv[1] = cvt_pk(hv[i][2], hv[i][3]);
            *(u32x2*)(HB + (size_t)m * 1024 + 256 * i + 4 * lane) = wv;
        }
        float a[8];
#pragma unroll
        for (int j = 0; j < 8; ++j) a[j] = 0.f;
#pragma unroll
        for (int i = 0; i < 4; ++i)
#pragma unroll
            for (int e = 0; e < 4; ++e) {
                const float x = hv[i][e];
                a[0] += x * w0[i][e][0]; a[1] += x * w0[i][e][1]; a[2] += x * w0[i][e][2]; a[3] += x * w0[i][e][3];
                a[4] += x * w1[i][e][0]; a[5] += x * w1[i][e][1]; a[6] += x * w1[i][e][2]; a[7] += x * w1[i][e][3];
            }
        const bool b5 = (lane & 32) != 0, b4 = (lane & 16) != 0, b3 = (lane & 8) != 0;
        float c4[4];
#pragma unroll
        for (int j = 0; j < 4; ++j) { const float send = b5 ? a[j] : a[j + 4]; const float keep = b5 ? a[j + 4] : a[j]; c4[j] = keep + __shfl_xor(send, 32); }
        float c2[2];
#pragma unroll
        for (int j = 0; j < 2; ++j) { const float send = b4 ? c4[j] : c4[j + 2]; const float keep = b4 ? c4[j + 2] : c4[j]; c2[j] = keep + __shfl_xor(send, 16); }
        float v;
        { const float send = b3 ? c2[0] : c2[1]; const float keep = b3 ? c2[1] : c2[0]; v = keep + __shfl_xor(send, 8); }
        v += __shfl_xor(v, 4); v += __shfl_xor(v, 2); v += __shfl_xor(v, 1);
        if ((lane & 7) == 0) {
            const float xx = v + fbias;
            const float ls = fminf(xx, 0.f) - log1pf(expf(-fabsf(xx)));
            const int b = m / LT, pos = m - b * LT;
            LF[(size_t)(b * 8 + j8) * LP + pos] = ls;
        }
    }
}

DI void ph_cumsum(const Params& p, bf16_t* smem) {
    float* sm = (float*)smem;
    const int tid = opaque_tid(), lane = tid & 63, w = tid >> 6;
    const float* LF = (const float*)(p.ws + OFF_LOGF);
    float* CF = (float*)(p.ws + OFF_CUMF);
    for (int it = blockIdx.x; it < 32; it += gridDim.x) {
        const float* src = LF + (size_t)it * LP; float* dst = CF + (size_t)it * LP;
        const int p0 = tid * 17;
        float v[17];
#pragma unroll
        for (int i = 0; i < 17; ++i) { const int pos = p0 + i; v[i] = (pos < LT) ? src[pos] : 0.f; }
        float s = 0.f;
#pragma unroll
        for (int i = 0; i < 17; ++i) s += v[i];
        float incl = s;
#pragma unroll
        for (int o = 1; o < 64; o <<= 1) { const float t = __shfl_up(incl, o); if (lane >= o) incl += t; }
        __syncthreads();
        if (lane == 63) sm[w] = incl;
        __syncthreads();
        float run = incl - s;
        for (int w2 = 0; w2 < w; ++w2) run += sm[w2];
#pragma unroll
        for (int i = 0; i < 17; ++i) { const int pos = p0 + i; run += v[i]; if (pos < LP) dst[pos] = run * LOG2E; }
    }
}

template <int DV, bool FOX>
DI void flash(f32x16 (&O)[DV / 32], const bf16_t* __restrict__ qptr, const bf16_t* __restrict__ kg, const bf16_t* __restrict__ vtg,
              int ntiles, int q, float slope2, const float* __restrict__ cum2, float KN, bf16_t* smem) {
    constexpr int NDT = DV / 32;
    constexpr int KS_ELEMS = 64 * 72, VS_ELEMS = DV * 72, BUF = KS_ELEMS + VS_ELEMS;
    const int tid = opaque_tid(), lane = tid & 63, r = lane & 31, h = lane >> 5;
    const int w = tid >> 6;
    const int pr = perm23(r);
    const int cc = tid & 7, r0 = tid >> 3;
    int* flags = (int*)(dsm + SMEM_BYTES - 256);
    bf16x8 qf[4];
#pragma unroll
    for (int ks = 0; ks < 4; ++ks) qf[ks] = *(const bf16x8*)(qptr + ks * 16 + h * 8);
    float qn2 = 0.f;
#pragma unroll
    for (int ks = 0; ks < 4; ++ks)
#pragma unroll
        for (int j = 0; j < 8; ++j) { const float x = __uint_as_float(((unsigned)(unsigned short)qf[ks][j]) << 16); qn2 += x * x; }
    qn2 = xsum32(qn2);
    const float c1 = 0.125f * LOG2E;
    const float sbound = sqrtf(qn2) * KN * c1 * 1.001f + 0.01f;
    float m = -1e30f, l = 0.f;
#pragma unroll
    for (int dt = 0; dt < NDT; ++dt) O[dt] = zero16();
    const float cq = FOX ? cum2[min(q, LT - 1)] : 0.f;
    const int kend = FOX ? q + 1 : 16 + 64 * ((q + 48) >> 6);
    const int wkend = __builtin_amdgcn_readfirstlane(FOX ? (q | 31) + 1 : 16 + 64 * (((q | 31) + 48) >> 6));
    const int qlo = __builtin_amdgcn_readfirstlane(q & ~31);

    constexpr int NVR = DV / 64;
    u32x4 kr[2], vr[2][NVR];
#define LOAD_PAIR(ktA) do { _Pragma("unroll") for (int j_ = 0; j_ < 2; ++j_) { const int kt_ = (ktA) - j_; if (kt_ >= 0) { const int kb_ = kt_ * 64; \
        { const int krow = min(kb_ + r0, LT - 1); kr[j_] = *(const u32x4*)(kg + (size_t)krow * 2048 + cc * 8); } \
        _Pragma("unroll") for (int i = 0; i < NVR; ++i) vr[j_][i] = *(const u32x4*)(vtg + ((size_t)kt_ * 4096 + r0 + 64 * i) * 64 + cc * 8); } } } while (0)
#define STORE_PAIR(stage) do { _Pragma("unroll") for (int j_ = 0; j_ < 2; ++j_) { bf16_t* Kd = smem + ((stage) * 2 + j_) * BUF; bf16_t* Vd = Kd + KS_ELEMS; \
        *(u32x4*)(Kd + r0 * 72 + cc * 8) = kr[j_]; \
        _Pragma("unroll") for (int i = 0; i < NVR; ++i) *(u32x4*)(Vd + (r0 + 64 * i) * 72 + cc * 8) = vr[j_][i]; } } while (0)
    kr[0] = kr[1] = (u32x4){0u, 0u, 0u, 0u};
#pragma unroll
    for (int i = 0; i < NVR; ++i) vr[0][i] = vr[1][i] = (u32x4){0u, 0u, 0u, 0u};
    LOAD_PAIR(ntiles - 1);
    STORE_PAIR(0);
    __syncthreads();
    bool wskip = false;
    const int npairs = (ntiles + 1) >> 1;
    for (int pit = 0; pit < npairs; ++pit) {
        const int kt0 = ntiles - 1 - 2 * pit;
        const int cur = pit & 1;
        const bool more = pit + 1 < npairs;
        if (more) LOAD_PAIR(kt0 - 2);
        float ckl0 = 0.f, ckl1 = 0.f;
        if (FOX) { if (kt0 > 0) ckl0 = cum2[kt0 * 64 - 1]; if (kt0 > 1) ckl1 = cum2[(kt0 - 1) * 64 - 1]; }
#pragma unroll 1
        for (int pj = 0; pj < 2; ++pj) {
        const int kt = kt0 - pj;
        if (kt < 0) break;
        const bf16_t* Ks = smem + (cur * 2 + pj) * BUF; const bf16_t* Vs = Ks + KS_ELEMS;
        const int kb = kt * 64;
        const float cklast = pj ? ckl1 : ckl0;
        if (kb < wkend && !wskip) {
        f32x16 s[2];
#pragma unroll
        for (int sub = 0; sub < 2; ++sub) {
            s[sub] = zero16();
#pragma unroll
            for (int ks = 0; ks < 4; ++ks) {
                const bf16x8 a = *(const bf16x8*)(Ks + (sub * 32 + pr) * 72 + ks * 16 + h * 8);
                s[sub] = mfma32(a, qf[ks], s[sub]);
            }
        }
        float mx = -INFINITY;
        if (kb + 63 < qlo) {
#pragma unroll
            for (int sub = 0; sub < 2; ++sub) {
#pragma unroll
                for (int i8 = 0; i8 < 2; ++i8) {
                    const int k0 = kb + sub * 32 + 16 * i8 + 8 * h;
                    float ck[8];
                    float base = 0.f;
                    if (FOX) {
                        const f32x4 c0 = *(const f32x4*)(cum2 + k0), c1v = *(const f32x4*)(cum2 + k0 + 4);
                        ck[0] = c0[0]; ck[1] = c0[1]; ck[2] = c0[2]; ck[3] = c0[3]; ck[4] = c1v[0]; ck[5] = c1v[1]; ck[6] = c1v[2]; ck[7] = c1v[3];
                    } else base = -slope2 * (float)(q - k0);
#pragma unroll
                    for (int e = 0; e < 8; ++e) {
                        const float bias = FOX ? cq - ck[e] : fmaf(slope2, (float)e, base);
                        const float t = fmaf(s[sub][8 * i8 + e], c1, bias);
                        s[sub][8 * i8 + e] = t;
                        mx = fmaxf(mx, t);
                    }
                }
            }
        } else {
#pragma unroll
            for (int sub = 0; sub < 2; ++sub) {
#pragma unroll
                for (int i8 = 0; i8 < 2; ++i8) {
                    const int k0 = kb + sub * 32 + 16 * i8 + 8 * h;
                    float ck[8];
                    if (FOX) {
                        const f32x4 c0 = *(const f32x4*)(cum2 + k0), c1v = *(const f32x4*)(cum2 + k0 + 4);
                        ck[0] = c0[0]; ck[1] = c0[1]; ck[2] = c0[2]; ck[3] = c0[3]; ck[4] = c1v[0]; ck[5] = c1v[1]; ck[6] = c1v[2]; ck[7] = c1v[3];
                    }
#pragma unroll
                    for (int e = 0; e < 8; ++e) {
                        const int k = k0 + e;
                        float t = s[sub][8 * i8 + e] * c1;
                        if (FOX) t += cq - ck[e];
                        else t -= slope2 * fabsf((float)(q - k));
                        t = (k < kend) ? t : -INFINITY;
                        s[sub][8 * i8 + e] = t;
                        mx = fmaxf(mx, t);
                    }
                }
            }
        }
        mx = xmax32(mx);
        const float mn = fmaxf(m, mx);
        if (__any(mn > m)) {
            const float alpha = ex2(m - mn);
            l *= alpha;
#pragma unroll
            for (int dt = 0; dt < NDT; ++dt)
#pragma unroll
                for (int i = 0; i < 16; ++i) O[dt][i] *= alpha;
        }
        m = mn;
#pragma unroll
        for (int sub = 0; sub < 2; ++sub)
#pragma unroll
            for (int i = 0; i < 16; ++i) { const float pv = ex2(s[sub][i] - mn); s[sub][i] = pv; l += pv; }
        bf16x8 pf[2][2];
        pf[0][0] = pack8<0>(s[0]); pf[0][1] = pack8<1>(s[0]); pf[1][0] = pack8<0>(s[1]); pf[1][1] = pack8<1>(s[1]);
#pragma unroll
        for (int dt = 0; dt < NDT; ++dt)
#pragma unroll
            for (int sub = 0; sub < 2; ++sub)
#pragma unroll
                for (int s2 = 0; s2 < 2; ++s2) {
                    const bf16x8 a = *(const bf16x8*)(Vs + (dt * 32 + r) * 72 + sub * 32 + 16 * s2 + 8 * h);
                    O[dt] = mfma32(a, pf[sub][s2], O[dt]);
                }
        }
        if (kt > 0) {
            const int klast = kb - 1;
            float bm = 0.f;
            if (klast < q) bm = FOX ? cq - cklast : -slope2 * (float)(q - klast);
            const bool pred = (q >= LT) || (sbound + bm < m - 152.f);
            wskip = __all(pred);
        }
        }
        if (more) {
            if (lane == 0) flags[cur * 8 + w] = wskip ? 1 : 0;
            STORE_PAIR(cur ^ 1);
        }
        __syncthreads();
        if (more) {
            const int4 f0 = *(const int4*)(flags + cur * 8), f1 = *(const int4*)(flags + cur * 8 + 4);
            if ((f0.x & f0.y & f0.z & f0.w & f1.x & f1.y & f1.z & f1.w) != 0) break;
        }
    }
#undef LOAD_PAIR
#undef STORE_PAIR
    l = xsum32(l);
    const float inv = 1.0f / l;
#pragma unroll
    for (int dt = 0; dt < NDT; ++dt)
#pragma unroll
        for (int i = 0; i < 16; ++i) O[dt][i] *= inv;
}

DI void ph_knorm(const Params& p) {
    const int tid = opaque_tid(), lane = tid & 63;
    const int gw = blockIdx.x * 8 + (tid >> 6), nw = gridDim.x * 8;
    const bf16_t* PQK = (const bf16_t*)(p.ws + OFF_PQK);
    unsigned* knm = (unsigned*)(p.ws + OFF_CNT) + 128;
    for (int u = gw; u < BATCH * 456; u += nw) {
        const int b = u / 456, ch = u - b * 456;
        float mxa = 0.f, mxb = 0.f;
        const bf16_t* base = PQK + ((size_t)b * LT + ch * 18) * 2048 + lane * 8;
#pragma unroll
        for (int i = 0; i < 18; ++i) {
            const u32x4 va = *(const u32x4*)(base + (size_t)i * 2048 + 512), vb = *(const u32x4*)(base + (size_t)i * 2048 + 1536);
            float sa = 0.f, sb = 0.f;
#pragma unroll
            for (int e = 0; e < 4; ++e) {
                const float a0 = __uint_as_float(va[e] << 16), a1 = __uint_as_float(va[e] & 0xffff0000u);
                const float b0 = __uint_as_float(vb[e] << 16), b1 = __uint_as_float(vb[e] & 0xffff0000u);
                sa += a0 * a0 + a1 * a1; sb += b0 * b0 + b1 * b1;
            }
            sa += __shfl_xor(sa, 1); sa += __shfl_xor(sa, 2); sa += __shfl_xor(sa, 4);
            sb += __shfl_xor(sb, 1); sb += __shfl_xor(sb, 2); sb += __shfl_xor(sb, 4);
            mxa = fmaxf(mxa, sa); mxb = fmaxf(mxb, sb);
        }
        if ((lane & 7) == 0) {
            atomicMax(knm + b * 16 + (lane >> 3), __float_as_uint(mxa));
            atomicMax(knm + b * 16 + 8 + (lane >> 3), __float_as_uint(mxb));
        }
    }
}

DI void ph_attn(const Params& p, bf16_t* smem, int* s_item) {
    const int tid = opaque_tid(), lane = tid & 63, w = tid >> 6, r = lane & 31, h = lane >> 5;
    const bf16_t* PQK = (const bf16_t*)(p.ws + OFF_PQK);
    bf16_t* MIX = (bf16_t*)(p.ws + OFF_HB);
    const float lam = ((const float*)(p.ws + OFF_MISC))[0];
    unsigned* ctr = (unsigned*)(p.ws + OFF_CNT);
    const unsigned* knm = (const unsigned*)(p.ws + OFF_CNT) + 128;
    constexpr int NQB = 33, NDIFF = NQB * 16, NITEM = NQB * 48;
    for (;;) {
        __syncthreads();
        if (tid == 0) *s_item = (int)atomicAdd(ctr, 1u);
        __syncthreads();
        const int it = *s_item;
        if (it >= NITEM) break;
        const int cls = it / 132, jj = it - cls * 132;
        const int code = (int)((0xBA7654932108ull >> (4 * (11 - cls))) & 15ull);
        const int qbi = NQB - 1 - (jj >> 2), bi = jj & 3;
        if (code & 8) {
            const int qb = qbi;
            const int q = qb * 256 + w * 32 + r;
            const int b = bi, hd = code & 7;
            const int ntiles = (min(LT, qb * 256 + 272) + 63) >> 6;
            const size_t qrow = (size_t)b * LT + min(q, LT - 1);
            const float slope2 = ex2(-2.f * (float)(hd + 1)) * LOG2E;
            const bf16_t* vt = (const bf16_t*)(p.ws + OFF_VTA) + (size_t)(b * 512 + hd * 128) * 64;
            f32x16 O0[4];
            float* scr = p.out + (size_t)blockIdx.x * 32768 + tid * 64;
            flash<128, false>(O0, PQK + qrow * 2048 + hd * 128, PQK + (size_t)b * LT * 2048 + 512 + hd * 128, vt, ntiles, q, slope2, nullptr, sqrtf(__uint_as_float(knm[b * 16 + hd * 2])), smem);
#pragma unroll
            for (int dt = 0; dt < 4; ++dt)
#pragma unroll
                for (int g = 0; g < 4; ++g) *(f32x4*)(scr + dt * 16 + 4 * g) = (f32x4){O0[dt][4 * g], O0[dt][4 * g + 1], O0[dt][4 * g + 2], O0[dt][4 * g + 3]};
            flash<128, false>(O0, PQK + qrow * 2048 + hd * 128 + 64, PQK + (size_t)b * LT * 2048 + 512 + hd * 128 + 64, vt, ntiles, q, slope2, nullptr, sqrtf(__uint_as_float(knm[b * 16 + hd * 2 + 1])), smem);
            float ss = 0.f;
#pragma unroll
            for (int dt = 0; dt < 4; ++dt)
#pragma unroll
                for (int g = 0; g < 4; ++g) {
                    const f32x4 pv = *(const f32x4*)(scr + dt * 16 + 4 * g);
#pragma unroll
                    for (int e = 0; e < 4; ++e) { const float o = pv[e] - lam * O0[dt][4 * g + e]; O0[dt][4 * g + e] = o; ss += o * o; }
                }
            ss = xsum32(ss);
            const float rn = __frsqrt_rn(ss * (1.0f / 128.0f) + 1e-6f) * 0.8f;
            if (q < LT) {
                bf16_t* d = MIX + qrow * 1024 + hd * 128;
#pragma unroll
                for (int dt = 0; dt < 4; ++dt)
#pragma unroll
                    for (int g = 0; g < 4; ++g) {
                        const int dv = dt * 32 + 8 * g + 4 * h;
                        const f32x4 gg = *(const f32x4*)(p.subln + dv);
                        u32x2 wv; wv[0] = cvt_pk(O0[dt][4 * g] * rn * gg[0], O0[dt][4 * g + 1] * rn * gg[1]);
                        wv[1] = cvt_pk(O0[dt][4 * g + 2] * rn * gg[2], O0[dt][4 * g + 3] * rn * gg[3]);
                        *(u32x2*)(d + dv) = wv;
                    }
            }
        } else {
            const int qb = qbi;
            const int q = qb * 256 + w * 32 + r;
            const int b = bi, hf = code & 7;
            const int ntiles = (min(LT, qb * 256 + 256) + 63) >> 6;
            const size_t qrow = (size_t)b * LT + min(q, LT - 1);
            const bf16_t* vt = (const bf16_t*)(p.ws + OFF_VTA) + (size_t)(2048 + b * 512 + hf * 64) * 64;
            f32x16 O[2];
            flash<64, true>(O, PQK + qrow * 2048 + 1024 + hf * 64, PQK + (size_t)b * LT * 2048 + 1536 + hf * 64, vt, ntiles, q, 0.f,
                            (const float*)(p.ws + OFF_CUMF) + (size_t)(b * 8 + hf) * LP, sqrtf(__uint_as_float(knm[b * 16 + 8 + hf])), smem);
            if (q < LT) {
                bf16_t* d = MIX + qrow * 1024 + 512 + hf * 64;
#pragma unroll
                for (int dt = 0; dt < 2; ++dt)
#pragma unroll
                    for (int g = 0; g < 4; ++g) {
                        const int dv = dt * 32 + 8 * g + 4 * h;
                        u32x2 wv; wv[0] = cvt_pk(O[dt][4 * g], O[dt][4 * g + 1]); wv[1] = cvt_pk(O[dt][4 * g + 2], O[dt][4 * g + 3]);
                        *(u32x2*)(d + dv) = wv;
                    }
            }
        }
    }
}

DI void ph_ln(const Params& p, int lnidx, bool last) {
    const int lane = opaque_tid() & 63;
    const int gw = blockIdx.x * 8 + (opaque_tid() >> 6), nw = gridDim.x * 8;
    float* H = (float*)(p.ws + OFF_H); bf16_t* HB = (bf16_t*)(p.ws + OFF_HB);
    const float* G = p.ln_g + (size_t)lnidx * 1024; const float* Bv = p.ln_b + (size_t)lnidx * 1024;
    f32x4 g[4], bb[4];
#pragma unroll
    for (int i = 0; i < 4; ++i) { g[i] = *(const f32x4*)(G + i * 256 + lane * 4); bb[i] = *(const f32x4*)(Bv + i * 256 + lane * 4); }
    f32x4 nv[4];
    if (gw < MT) {
#pragma unroll
        for (int i = 0; i < 4; ++i) nv[i] = *(const f32x4*)(H + (size_t)gw * 1024 + i * 256 + lane * 4);
    }
    for (int m = gw; m < MT; m += nw) {
        f32x4 v[4];
#pragma unroll
        for (int i = 0; i < 4; ++i) v[i] = nv[i];
        const int mn = min(m + nw, MT - 1);
#pragma unroll
        for (int i = 0; i < 4; ++i) nv[i] = *(const f32x4*)(H + (size_t)mn * 1024 + i * 256 + lane * 4);
        float s = 0.f;
#pragma unroll
        for (int i = 0; i < 4; ++i) s += (v[i][0] + v[i][1]) + (v[i][2] + v[i][3]);
        for (int o = 32; o > 0; o >>= 1) s += __shfl_xor(s, o);
        const float mu = s * (1.0f / 1024.0f);
        float qv = 0.f;
#pragma unroll
        for (int i = 0; i < 4; ++i)
#pragma unroll
            for (int e = 0; e < 4; ++e) { const float d = v[i][e] - mu; qv += d * d; }
        for (int o = 32; o > 0; o >>= 1) qv += __shfl_xor(qv, o);
        const float rstd = __frsqrt_rn(qv * (1.0f / 1024.0f) + 1e-5f);
        const int b = m / LT, pos = m - b * LT;
#pragma unroll
        for (int i = 0; i < 4; ++i) {
            const int c = i * 256 + lane * 4;
            f32x4 y;
#pragma unroll
            for (int e = 0; e < 4; ++e) y[e] = (v[i][e] - mu) * rstd * g[i][e] + bb[i][e];
            if (last) {
                if (pos >= 16) *(f32x4*)(p.out + ((size_t)b * 8192 + (pos - 16)) * 1024 + c) = y;
            } else {
                u32x2 wv; wv[0] = cvt_pk(y[0], y[1]); wv[1] = cvt_pk(y[2], y[3]);
                *(u32x2*)(HB + (size_t)m * 1024 + c) = wv;
            }
        }
        if (!last && lane == 0) ((f32x2*)((unsigned char*)p.out + OFFO_STATS))[m] = (f32x2){mu, rstd};
    }
}

DI void ph_zero_ret_pads(const Params& p) {
    const int tid = opaque_tid();
    for (int idx = blockIdx.x * NT + tid; idx < (128 + 256) * 3 * 64; idx += gridDim.x * NT) {
        const int ch16 = idx & 63, blk = idx >> 6, s_ = blk % 3, g = blk / 3;
        bf16_t* base = g < 128 ? (bf16_t*)(p.ws + OFF_KHATT) + (size_t)(g * 4 + s_) * 512 : (bf16_t*)(p.ws + OFF_VT1) + (size_t)((g - 128) * 4 + s_) * 512;
        *(u32x4*)(base + ch16 * 8) = (u32x4){0u, 0u, 0u, 0u};
    }
}

DI void ph_sprep(const Params& p) {
    const int tid = opaque_tid(), lane = tid & 63, w = tid >> 6, r = lane & 31, h = lane >> 5;
    const int it_ = (w >> 1) & 1, jt = w & 1;
    const bf16_t* QH = (const bf16_t*)((unsigned char*)p.out + OFFO_QHAT);
    const bf16_t* KH = (const bf16_t*)(p.ws + OFF_KHAT);
    bf16_t* SB = (bf16_t*)((unsigned char*)p.out + OFFO_SBUF);
    for (int item = blockIdx.x * 2 + (w >> 2); item < NCH * 16; item += gridDim.x * 2) {
        const int c = item >> 4, b = (item >> 2) & 3, hd = item & 3;
        const int ppi = c * 64 + it_ * 32 + r, ppj = c * 64 + jt * 32 + r;
        const bool vi = ppi >= 48, vj = ppj >= 48;
        const bf16_t* qp = QH + (size_t)item * 16384 + (size_t)it_ * 512 + lane * 8;
        const bf16_t* kp = KH + ((size_t)b * LT + (vj ? ppj - 48 : 0)) * 1024 + hd * 256 + h * 8;
        f32x16 acc = zero16();
        const bf16x8 z8 = {0, 0, 0, 0, 0, 0, 0, 0};
#pragma unroll 8
        for (int s = 0; s < 16; ++s) {
            bf16x8 a = *(const bf16x8*)(qp + ((s >> 1) * 4 + (s & 1) * 2) * 512), bq = *(const bf16x8*)(kp + s * 16);
            if (!vi) a = z8;
            if (!vj) bq = z8;
            acc = mfma32(a, bq, acc);
        }
        const float lg = log2f(1.f - ex2(-5.f - (float)hd));
        const int j = jt * 32 + r;
#pragma unroll
        for (int reg = 0; reg < 16; ++reg) {
            const int i = it_ * 32 + crow(reg, h);
            const int e = (i >= j) ? -64 : 2 * (j - i) - 64;
            SB[sf_off(item, i, j)] = f2bf(acc[reg] * ex2(lg * (float)e));
        }
    }
}

DI void scan_block(const Params& p, const int u) {
    const int tid = opaque_tid(), lane = tid & 63, r = lane & 31, h = lane >> 5;
    const int w = __builtin_amdgcn_readfirstlane(tid >> 6);
    const int sl = u & 15, hd = (u >> 4) & 3, b = u >> 6;
    const float lg = log2f(1.f - ex2(-5.f - (float)hd));
    const float cdec = ex2(lg * 64.f);
    const int it0 = b * 4 + hd;
    constexpr size_t KSTEP = (size_t)16 * 8 * 4 * 512, VSTEP = (size_t)16 * 16 * 4 * 512, SSTEP = (size_t)16 * 8 * 512;
    const bf16_t* KF = (const bf16_t*)(p.ws + OFF_KHATT) + (size_t)(it0 * 8 + w) * 4 * 512 + lane * 8;
    const bf16_t* VG = (const bf16_t*)(p.ws + OFF_VT1) + (size_t)(it0 * 16 + sl) * 4 * 512 + (w & 3) * 512 + lane * 8;
    bf16_t* OB = (bf16_t*)(p.ws + OFF_VT1) + (size_t)(it0 * 16 + sl) * 4 * 512;
    const bf16_t* QF = (const bf16_t*)((unsigned char*)p.out + OFFO_QHAT) + (size_t)(it0 * 8 + w) * 4 * 512 + lane * 8;
    const bf16_t* SF = (const bf16_t*)((unsigned char*)p.out + OFFO_SBUF) + (size_t)it0 * 8 * 512 + ((w >> 2) * 4 + (w & 3)) * 512 + lane * 8;
    float* PART = (float*)((unsigned char*)p.out + OFFO_PART);
    f32x4* red = (f32x4*)dsm;
    bf16_t* vlds = (bf16_t*)(dsm + SMEM_BYTES + 4096);
    const bf16x8 z8 = {0, 0, 0, 0, 0, 0, 0, 0};
    const bool ok0 = r >= 48 - 0, ok1 = false;
    (void)ok0; (void)ok1;

    f32x16 st = zero16();
    bf16x8 kaA[4], qA[2][2], sA, kaB[4], qB[2][2], sB, kaC[4], qC[2][2], sC;
    bf16x8 vg = z8, vg2 = z8;
#define LOADSET(KA_, Q_, S_, c_) do { const int cc_ = min((c_), NCH - 1); \
        _Pragma("unroll") for (int s_ = 0; s_ < 4; ++s_) KA_[s_] = *(const bf16x8*)(KF + cc_ * KSTEP + s_ * 512); \
        _Pragma("unroll") for (int it_ = 0; it_ < 2; ++it_) { \
            Q_[it_][0] = *(const bf16x8*)(QF + cc_ * KSTEP + (0 * 2 + it_) * 512); Q_[it_][1] = *(const bf16x8*)(QF + cc_ * KSTEP + (1 * 2 + it_) * 512); \
            if (cc_ * 64 + it_ * 32 + r < 48) { Q_[it_][0] = z8; Q_[it_][1] = z8; } } \
        S_ = *(const bf16x8*)(SF + cc_ * SSTEP); } while (0)
#define SCAN_STEP(c_, KA_, Q_, S_, KL_, QL_, SL_) do { const int c = (c_); \
        if (w < 4) { *(bf16x8*)(vlds + (((c + 1) & 1) * 4 + w) * 512 + lane * 8) = vg; vg = vg2; vg2 = *(const bf16x8*)(VG + (size_t)min(c + 3, NCH - 1) * VSTEP); } \
        LOADSET(KL_, QL_, SL_, c + 2); \
        bf16x8 vf[4]; \
        _Pragma("unroll") for (int s_ = 0; s_ < 4; ++s_) vf[s_] = *(const bf16x8*)(vlds + ((c & 1) * 4 + s_) * 512 + lane * 8); \
        const bf16x8 vw = *(const bf16x8*)(vlds + ((c & 1) * 4 + (w & 3)) * 512 + lane * 8); \
        f32x16 o0 = zero16(), o1 = zero16(); \
        if (w < 4) o0 = mfma32(vw, S_, o0); else o1 = mfma32(vw, S_, o1); \
        { const bf16x8 a0 = pack8<0>(st), a1 = pack8<1>(st); \
          o0 = mfma32(a0, Q_[0][0], o0); o1 = mfma32(a0, Q_[1][0], o1); o0 = mfma32(a1, Q_[0][1], o0); o1 = mfma32(a1, Q_[1][1], o1); } \
        _Pragma("unroll") for (int i = 0; i < 16; ++i) st[i] *= cdec; \
        _Pragma("unroll") for (int s_ = 0; s_ < 4; ++s_) st = mfma32(KA_[s_], vf[s_], st); \
        f32x4* rb = red + (size_t)(((c & 1) * 8 + w) * 8) * 64 + lane; \
        _Pragma("unroll") for (int g = 0; g < 4; ++g) { \
            rb[(0 * 4 + g) * 64] = (f32x4){o0[4 * g], o0[4 * g + 1], o0[4 * g + 2], o0[4 * g + 3]}; \
            rb[(1 * 4 + g) * 64] = (f32x4){o1[4 * g], o1[4 * g + 1], o1[4 * g + 2], o1[4 * g + 3]}; } \
        __syncthreads(); \
        { const int it2 = w >> 2, g2 = w & 3; \
          const f32x4* rr = red + (size_t)((c & 1) * 8 * 8 + it2 * 4 + g2) * 64 + lane; \
          f32x4 a = rr[0]; \
          _Pragma("unroll") for (int wv = 1; wv < 8; ++wv) { const f32x4 t = rr[(size_t)wv * 8 * 64]; a[0] += t[0]; a[1] += t[1]; a[2] += t[2]; a[3] += t[3]; } \
          const int pp = c * 64 + it2 * 32 + r; \
          float ss = (a[0] * a[0] + a[1] * a[1]) + (a[2] * a[2] + a[3] * a[3]); \
          ss = xsum32(ss); \
          const int i_ = it2 * 32 + r; \
          bf16_t* od = OB + c * VSTEP + (size_t)((i_ >> 4) * 64 + ((i_ >> 3) & 1) * 32 + 8 * g2 + 4 * h) * 8 + (i_ & 7); \
          od[0] = f2bf(a[0]); od[8] = f2bf(a[1]); od[16] = f2bf(a[2]); od[24] = f2bf(a[3]); \
          if (h == 0 && pp >= 48) PART[((size_t)b * LT + pp - 48) * 256 + hd * 64 + sl * 4 + g2] = ss; } } while (0)

    if (w < 4) { const bf16x8 v0 = *(const bf16x8*)(VG); *(bf16x8*)(vlds + w * 512 + lane * 8) = v0; vg = *(const bf16x8*)(VG + VSTEP); vg2 = *(const bf16x8*)(VG + 2 * VSTEP); }
    LOADSET(kaA, qA, sA, 0);
    LOADSET(kaB, qB, sB, 1);
    __syncthreads();
    for (int c3 = 0; c3 < NCH; c3 += 3) {
        SCAN_STEP(c3, kaA, qA, sA, kaC, qC, sC);
        SCAN_STEP(c3 + 1, kaB, qB, sB, kaA, qA, sA);
        SCAN_STEP(c3 + 2, kaC, qC, sC, kaB, qB, sB);
    }
#undef LOADSET
#undef SCAN_STEP
    __syncthreads();
}

DI void ph_scan(const Params& p) {
    for (int ub = blockIdx.x; ub < 256; ub += gridDim.x) {
        const int xcd = ub & 7, j = ub >> 3;
        scan_block(p, ((xcd * 2 + (j >> 4)) << 4) | (j & 15));
    }
}

constexpr int NPHASE = 18;
template <int ph>
DI void run_phase(const Params& p, bf16_t* smem, float* s_aux) {
    const bf16_t* HB = (const bf16_t*)(p.ws + OFF_HB);
    switch (ph) {
        case 0: ph_prologue(p, smem); ph_fb(p); break;
        case 1: ph_gemm<EPI_E1, 1024>(p, HB, (const bf16_t*)(p.ws + OFF_W0IN), 3072, s_aux); break;
        case 2: ph_cumsum(p, smem); ph_knorm(p); break;
        case 3: ph_attn(p, smem, (int*)(s_aux + 256)); break;
        case 4: ph_gemm<EPI_RESID, 1024>(p, HB, (const bf16_t*)(p.ws + OFF_W0OUT), 1024, s_aux); break;
        case 5: ph_ln(p, 0, false); break;
        case 6: ph_gemm<EPI_FFN1, 1024>(p, HB, (const bf16_t*)(p.ws + OFF_F1), 4096, s_aux); break;
        case 7: ph_gemm<EPI_RESID, 4096, 0>(p, (const bf16_t*)(p.ws + OFF_U), (const bf16_t*)(p.ws + OFF_F2), 1024, s_aux); break;
        case 8: ph_ln(p, 1, false); break;
        case 9: ph_zero_ret_pads(p); ph_gemm<EPI_E5, 1024>(p, HB, (const bf16_t*)(p.ws + OFF_W1IN), 4096, s_aux); break;
        case 10: ph_sprep(p); break;
        case 11: ph_scan(p); break;
        case 12: ph_gemm<EPI_E5B, 1024>(p, HB, (const bf16_t*)(p.ws + OFF_W1IN) + (size_t)4096 * 1024, 2048, s_aux); break;
        case 13: ph_gemm<EPI_RESID, 2048, 1>(p, (const bf16_t*)(p.ws + OFF_YB), (const bf16_t*)(p.ws + OFF_W1OUT), 1024, s_aux); break;
        case 14: ph_ln(p, 2, false); break;
        case 15: ph_gemm<EPI_FFN1, 1024>(p, HB, (const bf16_t*)(p.ws + OFF_F1 + SZ_F), 4096, s_aux); break;
        case 16: ph_gemm<EPI_RESID, 4096, 2>(p, (const bf16_t*)(p.ws + OFF_U), (const bf16_t*)(p.ws + OFF_F2 + SZ_F), 1024, s_aux); break;
        case 17: ph_ln(p, 3, true); break;
    }
}

__global__ void __launch_bounds__(512, 2) k_mega(Params p) {
    bf16_t* smem = (bf16_t*)dsm;
    float* s_aux = (float*)(dsm + SMEM_BYTES);
    uint4* xbw = (uint4*)(dsm + SMEM_BYTES + 1536);
    cg::grid_group grid = cg::this_grid();
    if (opaque_tid() == 0) *xbw = make_uint4(0u, 0u, 0u, 0u);
    __syncthreads();
    const XcdBarrier xb = xcd_barrier_post((unsigned*)(p.ws + OFF_BAR), (volatile LAS unsigned*)xbw);
    if (p.ws == nullptr) grid.sync();
#define PHS(N) run_phase<N>(p, smem, s_aux); xcd_barrier(xb);
    PHS(0) PHS(1) PHS(2) PHS(3) PHS(4) PHS(5) PHS(6) PHS(7) PHS(8) PHS(9) PHS(10) PHS(11) PHS(12) PHS(13) PHS(14) PHS(15) PHS(16)
    run_phase<17>(p, smem, s_aux);
}

extern "C" void kernel_launch(void* const* d_in, const int* in_sizes, int n_in, void* d_out, int out_size, void* d_ws, size_t ws_size, hipStream_t stream) {
    Params p{};
    p.x = (const float*)d_in[0]; p.meta = (const float*)d_in[1]; p.ew_in = (const float*)d_in[2]; p.ef_bias = (const float*)d_in[3];
    p.dlam = (const float*)d_in[4]; p.subln = (const float*)d_in[5]; p.ew_out = (const float*)d_in[6]; p.rw_in = (const float*)d_in[7];
    p.rw_out = (const float*)d_in[8]; p.ln_g = (const float*)d_in[9]; p.ln_b = (const float*)d_in[10]; p.f_w1 = (const float*)d_in[11];
    p.f_w2 = (const float*)d_in[12]; p.out = (float*)d_out; p.ws = (unsigned char*)d_ws;
    if (ws_size < WS_END) { fprintf(stderr, "workspace too small: %zu < %zu\n", ws_size, (size_t)WS_END); }
    static int grid_blocks = 0;
    if (!grid_blocks) {
        int dev = 0, cus = 0, per_cu = 0;
        hipGetDevice(&dev);
        hipDeviceGetAttribute(&cus, hipDeviceAttributeMultiprocessorCount, dev);
        (void)hipFuncSetAttribute((const void*)k_mega, hipFuncAttributeMaxDynamicSharedMemorySize, DSM_BYTES);
        (void)hipOccupancyMaxActiveBlocksPerMultiprocessor(&per_cu, k_mega, NT, DSM_BYTES);
        if (per_cu < 1) fprintf(stderr, "occupancy query returned %d\n", per_cu);
        grid_blocks = cus;
    }
    void* args[] = {&p};
    (void)hipMemsetAsync((unsigned char*)d_ws + OFF_BAR, 0, 16384 + 4096, stream);
    hipError_t e = hipLaunchCooperativeKernel((void*)k_mega, dim3(grid_blocks), dim3(NT), args, DSM_BYTES, stream);
    if (e != hipSuccess) fprintf(stderr, "cooperative launch failed: %s (grid %d)\n", hipGetErrorString(e), grid_blocks);
}
```

```cpp
#include <hip/hip_runtime.h>
#include <hip/hip_cooperative_groups.h>
#include <cstdio>
#include <cstdint>
namespace cg = cooperative_groups;

#ifndef MEGA
#define MEGA 1
#endif

#define DI __device__ __forceinline__
typedef unsigned short bf16_t;
typedef __attribute__((ext_vector_type(8))) short bf16x8;
typedef __attribute__((ext_vector_type(16))) float f32x16;
typedef __attribute__((ext_vector_type(4))) float f32x4;
typedef __attribute__((ext_vector_type(2))) float f32x2;
typedef __attribute__((ext_vector_type(2))) __bf16 bf16x2v;
typedef __attribute__((ext_vector_type(4))) unsigned u32x4;
typedef __attribute__((ext_vector_type(2))) unsigned u32x2;

constexpr int BATCH = 4, LT = 8208, MT = BATCH * LT  , LP = 8320, LR = 8256, DM = 1024;
constexpr int NTM = (MT + 127) / 128;
constexpr int NCH = 129;
constexpr float LOG2E = 1.4426950408889634f;
constexpr float ALPHA = 1.4142135623730951f;

constexpr size_t SZ_W0IN = 3072ull * 1024 * 2, SZ_W0OUT = 1024ull * 1024 * 2, SZ_W1IN = 6144ull * 1024 * 2, SZ_W1OUT = 1024ull * 2048 * 2, SZ_F = 4096ull * 1024 * 2;
constexpr size_t OFF_W0IN = 0;
constexpr size_t OFF_W0OUT = OFF_W0IN + SZ_W0IN;
constexpr size_t OFF_W1IN = OFF_W0OUT + SZ_W0OUT;
constexpr size_t OFF_W1OUT = OFF_W1IN + SZ_W1IN;
constexpr size_t OFF_F1 = OFF_W1OUT + SZ_W1OUT;
constexpr size_t OFF_F2 = OFF_F1 + 2 * SZ_F;
constexpr size_t OFF_H = OFF_F2 + 2 * SZ_F;
constexpr size_t OFF_HB = OFF_H + (size_t)MT * 1024 * 4;
constexpr size_t OFF_LOGF = OFF_HB + (size_t)MT * 1024 * 2;
constexpr size_t OFF_CUMF = OFF_LOGF + (size_t)BATCH * 8 * LP * 4;
constexpr size_t OFF_MISC = OFF_CUMF + (size_t)BATCH * 8 * LP * 4;
constexpr size_t OFF_BAR = OFF_MISC + 4096;
constexpr size_t OFF_CNT = OFF_BAR + 16384;
constexpr size_t OFF_R = OFF_MISC + 32768;
constexpr size_t OFF_PQK = OFF_R;
constexpr size_t OFF_VTA = OFF_PQK + (size_t)MT * 2048 * 2;
constexpr size_t OFF_VTB = OFF_VTA + (size_t)BATCH * 512 * LP * 2;
constexpr size_t OFF_U = OFF_R;
constexpr size_t OFF_KHAT = OFF_R;
constexpr size_t OFF_KHATT = OFF_KHAT + (size_t)MT * 1024 * 2;
constexpr size_t OFF_VT1 = OFF_KHATT + (size_t)BATCH * 1024 * LR * 2;
constexpr size_t OFF_YB = OFF_KHAT;
constexpr size_t WS_END = OFF_VT1 + (size_t)BATCH * 2048 * LR * 2;
static_assert(OFF_U + (size_t)MT * 4096 * 2 <= WS_END + 4000000, "ws");
static_assert(WS_END <= 536870912ull, "ws too big");
static_assert((size_t)MT * 2048 * 2 <= (OFF_VT1 - OFF_KHAT), "yb alias");
constexpr size_t OFFO_QHAT = 0;
constexpr size_t OFFO_SBUF = OFFO_QHAT + (size_t)NCH * 16 * 64 * 256 * 2;
constexpr size_t OFFO_PART = OFFO_SBUF + (size_t)NCH * 16 * 4096 * 2;
constexpr size_t OFFO_DUMMY = OFFO_PART + (size_t)MT * 256 * 4;
static_assert(OFFO_DUMMY + 256 * 512 * 4 <= 124ull * 1048576, "out scratch");
constexpr size_t OFFO_STATS = 124ull * 1048576;
static_assert(OFFO_STATS + (size_t)MT * 8 <= 134217728ull, "out scratch");

struct Params {
    const float *x, *meta, *ew_in, *ef_bias, *dlam, *subln, *ew_out, *rw_in, *rw_out, *ln_g, *ln_b, *f_w1, *f_w2;
    float* out;
    unsigned char* ws;
};

DI unsigned cvt_pk(float lo, float hi) { f32x2 v = {lo, hi}; bf16x2v b = __builtin_convertvector(v, bf16x2v); return __builtin_bit_cast(unsigned, b); }
DI bf16_t f2bf(float x) { return (bf16_t)(cvt_pk(x, 0.f) & 0xffffu); }
DI f32x16 mfma32(bf16x8 a, bf16x8 b, f32x16 c) { return __builtin_amdgcn_mfma_f32_32x32x16_bf16(a, b, c, 0, 0, 0); }
DI int crow(int reg, int h) { return (reg & 3) + 8 * (reg >> 2) + 4 * h; }
DI int perm23(int r) { return (r & 0x13) | ((r & 4) << 1) | ((r & 8) >> 1); }
template <int S> DI bf16x8 pack8(const f32x16& x) {
    u32x4 p;
    p[0] = cvt_pk(x[8 * S + 0], x[8 * S + 1]); p[1] = cvt_pk(x[8 * S + 2], x[8 * S + 3]);
    p[2] = cvt_pk(x[8 * S + 4], x[8 * S + 5]); p[3] = cvt_pk(x[8 * S + 6], x[8 * S + 7]);
    return __builtin_bit_cast(bf16x8, p);
}
DI f32x16 zero16() { f32x16 z; for (int i = 0; i < 16; ++i) z[i] = 0.f; return z; }
DI float ex2(float x) { return __builtin_amdgcn_exp2f(x); }
DI float xsum32(float x) { auto r = __builtin_amdgcn_permlane32_swap(__float_as_uint(x), __float_as_uint(x), false, false); return __uint_as_float(r[0]) + __uint_as_float(r[1]); }
DI float xmax32(float x) { auto r = __builtin_amdgcn_permlane32_swap(__float_as_uint(x), __float_as_uint(x), false, false); return fmaxf(__uint_as_float(r[0]), __uint_as_float(r[1])); }
DI int opaque_tid() { int t = threadIdx.x; asm volatile("" : "+v"(t)); return t; }


#define XB_TMO      128
#define XB_XCNT(j)  (256  + 64 * (j))
#define XB_XSUB(j)  (1280 + 64 * (j))
#define XB_XGEN(j)  (2304 + 64 * (j))
#define XB_TOP      3328
#define XB_TOPGEN   3392
#define XCD_BAR_WORDS 3456
#define XB_SPIN_CAP (1u << 20)
#define LAS __attribute__((address_space(3)))
DI unsigned xb_ld(unsigned* p) { return __hip_atomic_load(p, __ATOMIC_RELAXED, __HIP_MEMORY_SCOPE_AGENT); }
DI unsigned xb_add(unsigned* p, unsigned v) { return __hip_atomic_fetch_add(p, v, __ATOMIC_RELAXED, __HIP_MEMORY_SCOPE_AGENT); }
DI unsigned xb_xcc_id() { return (unsigned)__builtin_amdgcn_s_getreg((3 << 11) | 20) & 0xFu; }
#define XB_SPIN(cond, bar) do { unsigned _sp = 0; while (cond) { __builtin_amdgcn_s_sleep(1); \
    if ((++_sp & 255u) == 0u) { if (xb_ld(&(bar)[XB_TMO])) break; if (_sp > XB_SPIN_CAP) { atomicAdd(&(bar)[XB_TMO], 1u); break; } } } } while (0)
struct XcdBarrier { unsigned* bar; unsigned x; volatile LAS unsigned* st; };
DI XcdBarrier xcd_barrier_post(unsigned* bar, volatile LAS unsigned* st) {
    XcdBarrier b; b.bar = bar; b.x = xb_xcc_id(); b.st = st;
    if (opaque_tid() == 0) (void)xb_add(&bar[XB_XCNT(b.x)], 1u);
    return b;
}
DI void xcd_barrier_complete(unsigned* bar, unsigned x, unsigned& nloc, unsigned& nx) {
    const unsigned G = gridDim.x * gridDim.y * gridDim.z;
    unsigned sum, cnt, mine, sp = 0u;
    for (;;) {
        sum = 0u; cnt = 0u; mine = 0u;
#pragma unroll
        for (unsigned j = 0; j < 16; ++j) { const unsigned c = xb_ld(&bar[XB_XCNT(j)]); sum += c; cnt += (c > 0u) ? 1u : 0u; mine = (j == x) ? c : mine; }
        if (sum == G) break;
        __builtin_amdgcn_s_sleep(1);
        if ((++sp & 255u) == 0u) { if (xb_ld(&bar[XB_TMO])) break; if (sp > XB_SPIN_CAP) { atomicAdd(&bar[XB_TMO], 1u); break; } }
    }
    nloc = mine > 0u ? mine : 1u; nx = cnt > 0u ? cnt : 1u;
}
DI void xcd_barrier(const XcdBarrier& b) {
    asm volatile("s_waitcnt vmcnt(0)" ::: "memory");
    __syncthreads();
    if (opaque_tid() == 0) {
        unsigned* bar = b.bar;
        __builtin_amdgcn_s_waitcnt(0);
        unsigned nloc = b.st[0], nx = b.st[1];
        if (nloc == 0u) { xcd_barrier_complete(bar, b.x, nloc, nx); b.st[0] = nloc; b.st[1] = nx; }
        const unsigned old = xb_add(&bar[XB_XSUB(b.x)], 1u);
        const unsigned gen = old / nloc;
        if (old + 1u == (gen + 1u) * nloc) {
            __builtin_amdgcn_fence(__ATOMIC_RELEASE, "agent");
            asm volatile("s_waitcnt vmcnt(0)" ::: "memory");
            const unsigned og = xb_add(&bar[XB_TOP], 1u);
            const unsigned tg = og / nx;
            if (og + 1u == (tg + 1u) * nx) xb_add(&bar[XB_TOPGEN], 1u);
            else XB_SPIN(xb_ld(&bar[XB_TOPGEN]) == tg, bar);
            __builtin_amdgcn_fence(__ATOMIC_ACQUIRE, "agent");
            xb_add(&bar[XB_XGEN(b.x)], 1u);
            asm volatile("s_waitcnt vmcnt(0)" ::: "memory");
        } else {
            XB_SPIN(xb_ld(&bar[XB_XGEN(b.x)]) == gen, bar);
            __builtin_amdgcn_fence(__ATOMIC_ACQUIRE, "agent");
            asm volatile("s_waitcnt vmcnt(0)" ::: "memory");
        }
    }
    __syncthreads();
}


DI size_t qf_off(int item, int i, int dk) { return ((size_t)(((item * 8 + (dk >> 5)) * 2 + ((dk >> 4) & 1)) * 2 + (i >> 5)) * 64 + ((dk >> 3) & 1) * 32 + (i & 31)) * 8 + (dk & 7); }
DI size_t kf_off(int item, int dk, int j) { return ((size_t)((item * 8 + (dk >> 5)) * 4 + (j >> 4)) * 64 + ((j >> 3) & 1) * 32 + perm23(dk & 31)) * 8 + (j & 7); }
DI size_t vf_off(int item, int dvh, int j) { return ((size_t)((item * 16 + (dvh >> 5)) * 4 + (j >> 4)) * 64 + ((j >> 3) & 1) * 32 + (dvh & 31)) * 8 + (j & 7); }
DI size_t sf_off(int item, int i, int j) { return ((size_t)((item * 2 + (i >> 5)) * 4 + (j >> 4)) * 64 + ((j >> 3) & 1) * 32 + (i & 31)) * 8 + (j & 7); }

constexpr int NT = 512;
constexpr int SMEM_BYTES = 131072;
constexpr int DSM_BYTES = SMEM_BYTES + 4096 + 8192;
extern __shared__ __attribute__((aligned(16))) unsigned char dsm[];

DI void transpose_tile(const float* __restrict__ src, int ld, bf16_t* __restrict__ dst, int K, int k0, int n0, float* tile) {
    const int tid = opaque_tid();
#pragma unroll 4
    for (int i = 0; i < 8; ++i) { const int k = (tid >> 6) + 8 * i, n = tid & 63; tile[k * 65 + n] = src[(size_t)(k0 + k) * ld + n0 + n]; }
    __syncthreads();
#pragma unroll 4
    for (int i = 0; i < 8; ++i) { const int n = (tid >> 6) + 8 * i, k = tid & 63; dst[(size_t)(n0 + n) * K + k0 + k] = f2bf(tile[k * 65 + n]); }
    __syncthreads();
}

DI void ph_prologue(const Params& p, bf16_t* smem) {
    float* tile = (float*)smem;
    const int tid = opaque_tid();
    auto decode = [&](int it, const float*& sp, bf16_t*& dp, int& ld, int& K) {
        const float* src; int N; bf16_t* dst; int t = it;
        if (t < 768) { src = p.ew_in; ld = 3080; K = 1024; N = 3072; dst = (bf16_t*)(p.ws + OFF_W0IN); }
        else if ((t -= 768) < 256) { src = p.ew_out; ld = 1024; K = 1024; N = 1024; dst = (bf16_t*)(p.ws + OFF_W0OUT); }
        else if ((t -= 256) < 1536) { src = p.rw_in; ld = 6144; K = 1024; N = 6144; dst = (bf16_t*)(p.ws + OFF_W1IN); }
        else if ((t -= 1536) < 512) { src = p.rw_out; ld = 1024; K = 2048; N = 1024; dst = (bf16_t*)(p.ws + OFF_W1OUT); }
        else if ((t -= 512) < 2048) { const int l = t >> 10; t &= 1023; src = p.f_w1 + (size_t)l * 1024 * 4096; ld = 4096; K = 1024; N = 4096; dst = (bf16_t*)(p.ws + OFF_F1 + l * SZ_F); }
        else { t -= 2048; const int l = t >> 10; t &= 1023; src = p.f_w2 + (size_t)l * 4096 * 1024; ld = 1024; K = 4096; N = 1024; dst = (bf16_t*)(p.ws + OFF_F2 + l * SZ_F); }
        const int ntn = N >> 6, k0 = (t / ntn) * 64, n0 = (t % ntn) * 64;
        sp = src + (size_t)k0 * ld + n0;
        dp = dst + (size_t)n0 * K + k0;
    };
    {
        const int tr = tid >> 6, tc = tid & 63;
        int it = blockIdx.x;
        const float* sp = nullptr; bf16_t* dp = nullptr; int ld = 0, K = 0;
        float pre[8];
        if (it < 7168) {
            decode(it, sp, dp, ld, K);
#pragma unroll
            for (int i = 0; i < 8; ++i) pre[i] = sp[(size_t)(tr + 8 * i) * ld + tc];
        }
        while (it < 7168) {
#pragma unroll
            for (int i = 0; i < 8; ++i) tile[(tr + 8 * i) * 65 + tc] = pre[i];
            __syncthreads();
            bf16_t* dcur = dp; const int Kcur = K;
            const int itn = it + (int)gridDim.x;
            if (itn < 7168) {
                decode(itn, sp, dp, ld, K);
#pragma unroll
                for (int i = 0; i < 8; ++i) pre[i] = sp[(size_t)(tr + 8 * i) * ld + tc];
            }
#pragma unroll
            for (int i = 0; i < 8; ++i) dcur[(size_t)(tr + 8 * i) * Kcur + tc] = f2bf(tile[tc * 65 + tr + 8 * i]);
            __syncthreads();
            it = itn;
        }
    }
    bf16_t* VT = (bf16_t*)(p.ws + OFF_VTA);
    for (int idx = blockIdx.x * NT + tid; idx < 4096 * 6; idx += gridDim.x * NT) {
        const int row = idx / 6, c = idx % 6;
        *(u32x4*)(VT + ((size_t)128 * 4096 + row) * 64 + 16 + c * 8) = (u32x4){0u, 0u, 0u, 0u};
    }
    if (blockIdx.x == 0 && tid < 64) {
        float a = p.dlam[tid] * p.dlam[64 + tid], b = p.dlam[128 + tid] * p.dlam[192 + tid];
        for (int o = 32; o > 0; o >>= 1) { a += __shfl_xor(a, o); b += __shfl_xor(b, o); }
        if (tid == 0) ((float*)(p.ws + OFF_MISC))[0] = __expf(a) - __expf(b) + 0.2f;
    }
}

enum { EPI_E1 = 0, EPI_RESID = 1, EPI_FFN1 = 2, EPI_E5 = 3, EPI_E5B = 4 };

template <int EPI, int LNI = -1>
DI void epi_store(const Params& p, int row0, int col, int lrow0, float (&v)[4], const float* s_aux, const f32x2* rs = nullptr, float gg = 1.f, float bb = 0.f) {
    const int b = row0 / LT, pos = row0 - b * LT;
    if (EPI == EPI_E1) {
        const int seg = col >> 9, cs = col & 511;
        if (seg == 2 || seg == 5) {
            bf16_t* vt = (bf16_t*)(p.ws + OFF_VTA);
            u32x2 wv; wv[0] = cvt_pk(v[0], v[1]); wv[1] = cvt_pk(v[2], v[3]);
            *(u32x2*)(vt + ((size_t)(pos >> 6) * 4096 + (seg == 2 ? 0 : 2048) + b * 512 + cs) * 64 + (pos & 63)) = wv;
        } else {
            const int oc = (seg == 0 ? 0 : seg == 1 ? 512 : seg == 3 ? 1024 : 1536) + cs;
            bf16_t* d = (bf16_t*)(p.ws + OFF_PQK) + (size_t)row0 * 2048 + oc;
#pragma unroll
            for (int e = 0; e < 4; ++e) d[(size_t)e * 2048] = f2bf(v[e]);
        }
    } else if (EPI == EPI_RESID) {
        float* d = (float*)(p.ws + OFF_H) + (size_t)row0 * 1024 + col;
#pragma unroll
        for (int e = 0; e < 4; ++e) {
            float hprev = d[(size_t)e * 1024];
            if (LNI >= 0) hprev = (hprev - rs[e][0]) * rs[e][1] * gg + bb;
            d[(size_t)e * 1024] = ALPHA * hprev + v[e];
        }
    } else if (EPI == EPI_FFN1) {
        bf16_t* d = (bf16_t*)(p.ws + OFF_U) + (size_t)row0 * 4096 + col;
#pragma unroll
        for (int e = 0; e < 4; ++e) { const float t = fmaxf(v[e], 0.f); d[(size_t)e * 4096] = f2bf(t * t); }
    } else if (EPI == EPI_E5) {
        const int idx = (pos + 48) & 63, ch = (pos + 48) >> 6;
        if (col < 1024) {
            const int hd = col >> 8, item = (ch * 4 + b) * 4 + hd;
            bf16_t* d = (bf16_t*)((unsigned char*)p.out + OFFO_QHAT) + qf_off(item, idx, col & 255);
#pragma unroll
            for (int e = 0; e < 4; ++e) d[e * 8] = f2bf(v[e] * rs[e][0]);
        } else if (col < 2048) {
            const int c = col - 1024, hd = c >> 8, item = (ch * 4 + b) * 4 + hd;
            bf16_t* d = (bf16_t*)(p.ws + OFF_KHAT) + (size_t)row0 * 1024 + c;
#pragma unroll
            for (int e = 0; e < 4; ++e) { v[e] *= rs[e][1]; d[(size_t)e * 1024] = f2bf(v[e]); }
            u32x2 wv; wv[0] = cvt_pk(v[0], v[1]); wv[1] = cvt_pk(v[2], v[3]);
            *(u32x2*)((bf16_t*)(p.ws + OFF_KHATT) + kf_off(item, c & 255, idx)) = wv;
        } else {
            const int c = col - 2048, hd = c >> 9, item = (ch * 4 + b) * 4 + hd;
            u32x2 wv; wv[0] = cvt_pk(v[0], v[1]); wv[1] = cvt_pk(v[2], v[3]);
            *(u32x2*)((bf16_t*)(p.ws + OFF_VT1) + vf_off(item, c & 511, idx)) = wv;
        }
    } else if (EPI == EPI_E5B) {
        const u32x2 ov = *(const u32x2*)((const bf16_t*)(p.ws + OFF_VT1) + vf_off((((pos + 48) >> 6) * 4 + b) * 4 + (col >> 9), col & 511, (pos + 48) & 63));
        bf16_t* d = (bf16_t*)(p.ws + OFF_YB) + (size_t)row0 * 2048 + col;
#pragma unroll
        for (int e = 0; e < 4; ++e) {
            const unsigned ob = (e & 1) ? (ov[e >> 1] & 0xffff0000u) : (ov[e >> 1] << 16);
            const float o = __uint_as_float(ob);
            const float gte = v[e] / (1.f + __expf(-v[e]));
            d[(size_t)e * 2048] = f2bf(gte * o * s_aux[lrow0 + e]);
        }
    }
}

constexpr int G_BK = 64, G_HALF = 128, G_HT = G_HALF * G_BK;
DI int lds_byte(int r, int c) { const int st = (r >> 4) * 2 + (c >> 5), rr = r & 15, cc = c & 31, ob = rr * 64 + cc * 2; return st * 1024 + (ob ^ (((ob >> 9) & 1) << 5)); }
DI void stage_rc(int b, int& R, int& C) { const int st = b / 1024, sb = b % 1024, swz = sb ^ (((sb >> 9) & 1) << 5); R = (st >> 1) * 16 + swz / 64; C = (st & 1) * 32 + (swz % 64) / 2; }

template <int EPI, int K, int LNI>
DI void gemm_tail_unit(const Params& p, const bf16_t* __restrict__ A, const bf16_t* __restrict__ Bt, const int un, float* s_aux) {
    const int tid = opaque_tid(), lane = tid & 63, w = tid >> 6, r = lane & 31, h = lane >> 5;
    constexpr int ROW0 = 32768, KS = K / 8;
    const int col0 = un * 64;
    if (EPI == EPI_E5B) {
        if (tid < 64) {
            const int hd = col0 >> 9;
            const float* pp = (const float*)((unsigned char*)p.out + OFFO_PART) + (size_t)(ROW0 + tid) * 256 + hd * 64;
            float sacc = 0.f;
#pragma unroll
            for (int i = 0; i < 16; ++i) { const f32x4 v = *(const f32x4*)(pp + i * 4); sacc += (v[0] + v[1]) + (v[2] + v[3]); }
            s_aux[tid] = __frsqrt_rn(sacc * (1.0f / 512.0f) + 1e-6f);
        }
    }
    f32x16 acc[2][2];
    acc[0][0] = zero16(); acc[0][1] = zero16(); acc[1][0] = zero16(); acc[1][1] = zero16();
    const bf16_t* ap = A + (size_t)(ROW0 + r) * K + w * KS + h * 8;
    const bf16_t* bp = Bt + (size_t)(col0 + r) * K + w * KS + h * 8;
#pragma unroll 8
    for (int s = 0; s < KS / 16; ++s) {
        const bf16x8 a0 = *(const bf16x8*)(ap + s * 16), a1 = *(const bf16x8*)(ap + (size_t)32 * K + s * 16);
        const bf16x8 b0 = *(const bf16x8*)(bp + s * 16), b1 = *(const bf16x8*)(bp + (size_t)32 * K + s * 16);
        acc[0][0] = mfma32(a0, b0, acc[0][0]); acc[0][1] = mfma32(a0, b1, acc[0][1]);
        acc[1][0] = mfma32(a1, b0, acc[1][0]); acc[1][1] = mfma32(a1, b1, acc[1][1]);
    }
    float* red = (float*)dsm;
#pragma unroll
    for (int i = 0; i < 2; ++i)
#pragma unroll
        for (int j = 0; j < 2; ++j)
#pragma unroll
            for (int reg = 0; reg < 16; ++reg) red[((w * 4 + i * 2 + j) * 16 + reg) * 64 + lane] = acc[i][j][reg];
    __syncthreads();
    {
        const int tile = w >> 1, i = tile >> 1, j = tile & 1;
#pragma unroll
        for (int gg = 0; gg < 2; ++gg) {
            const int g = 2 * (w & 1) + gg;
            float v[4];
#pragma unroll
            for (int e = 0; e < 4; ++e) {
                float sacc = 0.f;
#pragma unroll
                for (int wv = 0; wv < 8; ++wv) sacc += red[((wv * 4 + tile) * 16 + 4 * g + e) * 64 + lane];
                v[e] = sacc;
            }
            const int lrow0 = i * 32 + 8 * g + 4 * h;
            f32x2 rs[4]; float lng = 1.f, lnb = 0.f;
            if (EPI == EPI_E5) {
                lng = log2f(1.f - ex2(-5.f - (float)((col0 >> 8) & 3)));
                const int idx_ = (((ROW0 + lrow0) % LT) + 48) & 63;
#pragma unroll
                for (int e = 0; e < 4; ++e) rs[e] = (f32x2){ex2(lng * (float)(idx_ + e + 1)), 0.0625f * ex2(lng * (float)(63 - idx_ - e))};
            }
            if (EPI == EPI_RESID && LNI >= 0) {
                const f32x2* st_ = (const f32x2*)((unsigned char*)p.out + OFFO_STATS) + ROW0 + lrow0;
#pragma unroll
                for (int e = 0; e < 4; ++e) rs[e] = st_[e];
                lng = p.ln_g[(LNI < 0 ? 0 : LNI) * 1024 + col0 + j * 32 + r]; lnb = p.ln_b[(LNI < 0 ? 0 : LNI) * 1024 + col0 + j * 32 + r];
            }
            epi_store<EPI, LNI>(p, ROW0 + lrow0, col0 + j * 32 + r, lrow0, v, s_aux, rs, lng, lnb);
        }
    }
    __syncthreads();
}

template <int EPI, int K, int LNI = -1>
DI void ph_gemm(const Params& p, const bf16_t* __restrict__ A, const bf16_t* __restrict__ Bt, int N, float* s_aux) {
    constexpr int NXCD = 8, WGM = 8;
    const int nM = 128, nN = N / 256, nwg = nM * nN;
    auto unit = [&](int it, int& pm, int& pn) {
        int wgid = it;
        { const int q = nwg / NXCD, r = nwg % NXCD, xcd = wgid % NXCD, off = wgid / NXCD; wgid = (xcd < r ? xcd * (q + 1) : r * (q + 1) + (xcd - r) * q) + off; }
        const int nig = WGM * nN, gid = wgid / nig, fm = gid * WGM, gsz = min(nM - fm, WGM);
        pm = fm + ((wgid % nig) % gsz); pn = (wgid % nig) / gsz;
    };
    bf16_t* shm = (bf16_t*)dsm;
    typedef __attribute__((address_space(3))) unsigned lds_u32;
    typedef __attribute__((address_space(3))) unsigned char lds_u8;
#define SA(b, h) (shm + ((b) * 2 + (h)) * G_HT)
#define SB(b, h) (shm + (4 + (b) * 2 + (h)) * G_HT)
#define STAGE(P, g) do { const char* g_ = (const char*)(g); \
        __builtin_amdgcn_global_load_lds((const unsigned*)(g_ + so0), (lds_u32*)((lds_u8*)(P) + sb0), 16, 0, 0); \
        __builtin_amdgcn_global_load_lds((const unsigned*)(g_ + so1), (lds_u32*)((lds_u8*)(P) + sb0 + 8192), 16, 0, 0); } while (0)
#define LDA(dst, b, h) for (int m = 0; m < 4; ++m) for (int k = 0; k < 2; ++k) \
        dst[m][k] = *reinterpret_cast<const bf16x8*>((char*)SA(b, h) + lds_byte(wr * 64 + m * 16 + fr, k * 32 + fq * 8))
#define LDB(dst, b, h) for (int n = 0; n < 2; ++n) for (int k = 0; k < 2; ++k) \
        dst[n][k] = *reinterpret_cast<const bf16x8*>((char*)SB(b, h) + lds_byte(wc * 32 + n * 16 + fr, k * 32 + fq * 8))
#define MMA(ai, bj, At_, Bt_) do { __builtin_amdgcn_s_setprio(1); \
        for (int m = 0; m < 4; ++m) for (int n = 0; n < 2; ++n) for (int k = 0; k < 2; ++k) \
            acc[ai][bj][m][n] = __builtin_amdgcn_mfma_f32_16x16x32_bf16(At_[m][k], Bt_[n][k], acc[ai][bj][m][n], 0, 0, 0); \
        __builtin_amdgcn_s_setprio(0); } while (0)
#define WAIT_V(n) asm volatile("s_waitcnt vmcnt(" #n ")" ::: "memory")
#define WAIT_L(n) asm volatile("s_waitcnt lgkmcnt(" #n ")" ::: "memory")
#define BAR __builtin_amdgcn_s_barrier()
#define SCHED __builtin_amdgcn_sched_barrier(0)
    const int wid = opaque_tid() >> 6, lane = opaque_tid() & 63, wr = wid >> 2, wc = wid & 3, fr = lane & 15, fq = lane >> 4;
    const int sb0 = opaque_tid() * 16;
    unsigned so0, so1;
    { int r_, c_; stage_rc(sb0, r_, c_); so0 = (unsigned)(r_ * K + c_) * 2u; stage_rc(sb0 + 8192, r_, c_); so1 = (unsigned)(r_ * K + c_) * 2u; }
    constexpr int nt = K / G_BK;
    constexpr size_t hstep = (size_t)G_HALF * K, kstep = G_BK;

    int it = blockIdx.x, pm, pn;
    unit(it, pm, pn);
    const bf16_t* cA = A + (size_t)pm * 256 * K; const bf16_t* cB = Bt + (size_t)pn * 256 * K;
    STAGE(SB(0, 0), cB); STAGE(SB(0, 1), cB + hstep); STAGE(SA(0, 0), cA); STAGE(SA(0, 1), cA + hstep);
    if (wr == 1) BAR;
    WAIT_V(2); BAR;
    STAGE(SB(1, 0), cB + kstep); STAGE(SA(1, 0), cA + kstep); STAGE(SB(1, 1), cB + hstep + kstep);
    WAIT_V(6); BAR;
    f32x4 acc[2][2][4][2] = {};
    bf16x8 At[4][2], B0[2][2], B1[2][2];
    int cnt = 0;
    for (;;) {
        const int itn = it + (int)gridDim.x;
        const bool has_next = itn < nwg;
        int npm = pm, npn = pn;
        if (has_next) unit(itn, npm, npn);
        const bf16_t* nA = A + (size_t)npm * 256 * K; const bf16_t* nB = Bt + (size_t)npn * 256 * K;
        const int brow = pm * 256, bcol = pn * 256;
        float* sa = s_aux + (cnt & 1) * 512;
        if (EPI == EPI_E5B) {
            if (opaque_tid() < 256) {
                const int row = brow + (int)opaque_tid(); const int hd = bcol >> 9;
                const float* pp = (const float*)((unsigned char*)p.out + OFFO_PART) + (size_t)row * 256 + hd * 64;
                float sacc = 0.f;
#pragma unroll
                for (int i = 0; i < 16; ++i) { const f32x4 v = *(const f32x4*)(pp + i * 4); sacc += (v[0] + v[1]) + (v[2] + v[3]); }
                sa[opaque_tid()] = __frsqrt_rn(sacc * (1.0f / 512.0f) + 1e-6f);
            }
        }
        for (int t = 0; t < nt; t += 2) {
            const bool last = (t == nt - 2);
            const bf16_t* a1 = cA + (size_t)(t + 1) * kstep;
            const bf16_t* a2 = last ? nA : cA + (size_t)(t + 2) * kstep; const bf16_t* b2 = last ? nB : cB + (size_t)(t + 2) * kstep;
            const bf16_t* a3 = a2 + kstep; const bf16_t* b3 = b2 + kstep;
            LDB(B0, 0, 0); LDB(B1, 0, 1); SCHED; LDA(At, 0, 0); STAGE(SA(1, 1), a1 + hstep);
            WAIT_V(8); WAIT_L(0); BAR; MMA(0, 0, At, B0); MMA(0, 1, At, B1); BAR; SCHED;
            LDA(At, 0, 1); STAGE(SB(0, 0), b2); STAGE(SB(0, 1), b2 + hstep); STAGE(SA(0, 0), a2);
            WAIT_V(8); WAIT_L(0); BAR; MMA(1, 0, At, B0); MMA(1, 1, At, B1); BAR; SCHED;
            LDB(B0, 1, 0); LDB(B1, 1, 1); SCHED; LDA(At, 1, 0); STAGE(SA(0, 1), a2 + hstep);
            WAIT_V(8); WAIT_L(0); BAR; MMA(0, 0, At, B0); MMA(0, 1, At, B1); BAR; SCHED;
            LDA(At, 1, 1); STAGE(SB(1, 0), b3); STAGE(SB(1, 1), b3 + hstep); STAGE(SA(1, 0), a3);
            WAIT_V(8); WAIT_L(0); BAR; MMA(1, 0, At, B0); MMA(1, 1, At, B1); BAR; SCHED;
        }
        if (wr == 0) BAR;
        {
            int oz = 0; asm volatile("" : "+v"(oz));
            float lg_[2][2], lb_[2][2];
#pragma unroll
            for (int bj = 0; bj < 2; ++bj)
#pragma unroll
                for (int n = 0; n < 2; ++n) {
                    lg_[bj][n] = 1.f; lb_[bj][n] = 0.f;
                    if (EPI == EPI_E5) lg_[bj][n] = log2f(1.f - ex2(-5.f - (float)((bcol >> 8) & 3)));
                    if (EPI == EPI_RESID && LNI >= 0) { const int c_ = bcol + bj * 128 + wc * 32 + n * 16 + fr; lg_[bj][n] = p.ln_g[(LNI < 0 ? 0 : LNI) * 1024 + c_]; lb_[bj][n] = p.ln_b[(LNI < 0 ? 0 : LNI) * 1024 + c_]; }
                }
#pragma unroll
            for (int ai = 0; ai < 2; ++ai)
#pragma unroll
                for (int m = 0; m < 4; ++m) {
                    const int lrow0 = ai * 128 + wr * 64 + m * 16 + fq * 4, row0 = brow + lrow0 + oz;
                    f32x2 rs[4];
                    if (EPI == EPI_RESID && LNI >= 0) {
                        const f32x2* st_ = (const f32x2*)((unsigned char*)p.out + OFFO_STATS) + row0;
#pragma unroll
                        for (int e = 0; e < 4; ++e) rs[e] = st_[e];
                    }
                    if (EPI == EPI_E5) {
                        const int idx_ = ((row0 % LT) + 48) & 63; const float lgh = lg_[0][0];
#pragma unroll
                        for (int e = 0; e < 4; ++e) rs[e] = (f32x2){ex2(lgh * (float)(idx_ + e + 1)), 0.0625f * ex2(lgh * (float)(63 - idx_ - e))};
                    }
#pragma unroll
                    for (int bj = 0; bj < 2; ++bj)
#pragma unroll
                        for (int n = 0; n < 2; ++n) {
                            float v[4];
#pragma unroll
                            for (int e = 0; e < 4; ++e) v[e] = acc[ai][bj][m][n][e];
                            epi_store<EPI, LNI>(p, row0, bcol + bj * 128 + wc * 32 + n * 16 + fr + oz, lrow0, v, sa, rs, lg_[bj][n], lb_[bj][n]);
                        }
                }
        }
        if (!has_next) break;
#pragma unroll
        for (int a = 0; a < 2; ++a)
#pragma unroll
            for (int b = 0; b < 2; ++b)
#pragma unroll
                for (int m = 0; m < 4; ++m)
#pragma unroll
                    for (int n = 0; n < 2; ++n) acc[a][b][m][n] = (f32x4){0.f, 0.f, 0.f, 0.f};
        pm = npm; pn = npn; cA = nA; cB = nB; it = itn; ++cnt;
        if (wr == 1) BAR;
    }
    WAIT_V(0);
    BAR;
#undef SA
#undef SB
#undef STAGE
#undef LDA
#undef LDB
#undef MMA
    __syncthreads();
    for (int un = blockIdx.x; un < N / 64; un += gridDim.x) gemm_tail_unit<EPI, K, LNI>(p, A, Bt, un, s_aux);
}

DI void ph_fb(const Params& p) {
    const int lane = opaque_tid() & 63;
    const int gw = blockIdx.x * 8 + (opaque_tid() >> 6), nw = gridDim.x * 8;
    float* H = (float*)(p.ws + OFF_H); bf16_t* HB = (bf16_t*)(p.ws + OFF_HB);
    float* LF = (float*)(p.ws + OFF_LOGF);
    f32x4 w0[4][4], w1[4][4];
#pragma unroll
    for (int i = 0; i < 4; ++i)
#pragma unroll
        for (int e = 0; e < 4; ++e) {
            const float* wp = p.ew_in + (size_t)(256 * i + 4 * lane + e) * 3080 + 3072;
            w0[i][e] = *(const f32x4*)wp; w1[i][e] = *(const f32x4*)(wp + 4);
        }
    const int j8 = ((lane >> 5) & 1) * 4 + ((lane >> 4) & 1) * 2 + ((lane >> 3) & 1);
    const float fbias = p.ef_bias[j8];
    for (int m = gw; m < MT; m += nw) {
        const int b_ = m / LT, pos_ = m - b_ * LT;
        const float* hrow = pos_ < 16 ? p.meta + (size_t)pos_ * 1024 : p.x + ((size_t)b_ * 8192 + (pos_ - 16)) * 1024;
        f32x4 hv[4];
#pragma unroll
        for (int i = 0; i < 4; ++i) hv[i] = *(const f32x4*)(hrow + 256 * i + 4 * lane);
#pragma unroll
        for (int i = 0; i < 4; ++i) {
            *(f32x4*)(H + (size_t)m * 1024 + 256 * i + 4 * lane) = hv[i];
            u32x2 wv; wv[0] = cvt_pk(hv[i][0], hv[i][1]); wv[1] = cvt_pk(hv[i][2], hv[i][3]);
            *(u32x2*)(HB + (size_t)m * 1024 + 256 * i + 4 * lane) = wv;
        }
        float a[8];
#pragma unroll
        for (int j = 0; j < 8; ++j) a[j] = 0.f;
#pragma unroll
        for (int i = 0; i < 4; ++i)
#pragma unroll
            for (int e = 0; e < 4; ++e) {
                const float x = hv[i][e];
                a[0] += x * w0[i][e][0]; a[1] += x * w0[i][e][1]; a[2] += x * w0[i][e][2]; a[3] += x * w0[i][e][3];
                a[4] += x * w1[i][e][0]; a[5] += x * w1[i][e][1]; a[6] += x * w1[i][e][2]; a[7] += x * w1[i][e][3];
            }
        const bool b5 = (lane & 32) != 0, b4 = (lane & 16) != 0, b3 = (lane & 8) != 0;
        float c4[4];
#pragma unroll
        for (int j = 0; j < 4; ++j) { const float send = b5 ? a[j] : a[j + 4]; const float keep = b5 ? a[j + 4] : a[j]; c4[j] = keep + __shfl_xor(send, 32); }
        float c2[2];
#pragma unroll
        for (int j = 0; j < 2; ++j) { const float send = b4 ? c4[j] : c4[j + 2]; const float keep = b4 ? c4[j + 2] : c4[j]; c2[j] = keep + __shfl_xor(send, 16); }
        float v;
        { const float send = b3 ? c2[0] : c2[1]; const float keep = b3 ? c2[1] : c2[0]; v = keep + __shfl_xor(send, 8); }
        v += __shfl_xor(v, 4); v += __shfl_xor(v, 2); v += __shfl_xor(v, 1);
        if ((lane & 7) == 0) {
            const float xx = v + fbias;
            const float ls = fminf(xx, 0.f) - log1pf(expf(-fabsf(xx)));
            const int b = m / LT, pos = m - b * LT;
            LF[(size_t)(b * 8 + j8) * LP + pos] = ls;
        }
    }
}

DI void ph_cumsum(const Params& p, bf16_t* smem) {
    float* sm = (float*)smem;
    const int tid = opaque_tid(), lane = tid & 63, w = tid >> 6;
    const float* LF = (const float*)(p.ws + OFF_LOGF);
    float* CF = (float*)(p.ws + OFF_CUMF);
    for (int it = blockIdx.x; it < 32; it += gridDim.x) {
        const float* src = LF + (size_t)it * LP; float* dst = CF + (size_t)it * LP;
        const int p0 = tid * 17;
        float v[17];
#pragma unroll
        for (int i = 0; i < 17; ++i) { const int pos = p0 + i; v[i] = (pos < LT) ? src[pos] : 0.f; }
        float s = 0.f;
#pragma unroll
        for (int i = 0; i < 17; ++i) s += v[i];
        float incl = s;
#pragma unroll
        for (int o = 1; o < 64; o <<= 1) { const float t = __shfl_up(incl, o); if (lane >= o) incl += t; }
        __syncthreads();
        if (lane == 63) sm[w] = incl;
        __syncthreads();
        float run = incl - s;
        for (int w2 = 0; w2 < w; ++w2) run += sm[w2];
#pragma unroll
        for (int i = 0; i < 17; ++i) { const int pos = p0 + i; run += v[i]; if (pos < LP) dst[pos] = run * LOG2E; }
    }
}

template <int DV, bool FOX>
DI void flash(f32x16 (&O)[DV / 32], const bf16_t* __restrict__ qptr, const bf16_t* __restrict__ kg, const bf16_t* __restrict__ vtg,
              int ntiles, int q, float slope2, const float* __restrict__ cum2, float KN, bf16_t* smem) {
    constexpr int NDT = DV / 32;
    constexpr int KS_ELEMS = 64 * 72, VS_ELEMS = DV * 72, BUF = KS_ELEMS + VS_ELEMS;
    const int tid = opaque_tid(), lane = tid & 63, r = lane & 31, h = lane >> 5;
    const int w = tid >> 6;
    const int pr = perm23(r);
    const int cc = tid & 7, r0 = tid >> 3;
    int* flags = (int*)(dsm + SMEM_BYTES - 256);
    bf16x8 qf[4];
#pragma unroll
    for (int ks = 0; ks < 4; ++ks) qf[ks] = *(const bf16x8*)(qptr + ks * 16 + h * 8);
    float qn2 = 0.f;
#pragma unroll
    for (int ks = 0; ks < 4; ++ks)
#pragma unroll
        for (int j = 0; j < 8; ++j) { const float x = __uint_as_float(((unsigned)(unsigned short)qf[ks][j]) << 16); qn2 += x * x; }
    qn2 = xsum32(qn2);
    const float c1 = 0.125f * LOG2E;
    const float sbound = sqrtf(qn2) * KN * c1 * 1.001f + 0.01f;
    float m = -1e30f, l = 0.f;
#pragma unroll
    for (int dt = 0; dt < NDT; ++dt) O[dt] = zero16();
    const float cq = FOX ? cum2[min(q, LT - 1)] : 0.f;
    const int kend = FOX ? q + 1 : 16 + 64 * ((q + 48) >> 6);
    const int wkend = __builtin_amdgcn_readfirstlane(FOX ? (q | 31) + 1 : 16 + 64 * (((q | 31) + 48) >> 6));
    const int qlo = __builtin_amdgcn_readfirstlane(q & ~31);

    constexpr int NVR = DV / 64;
    constexpr int TPB = FOX ? 3 : 2;
    u32x4 kr[TPB], vr[TPB][NVR];
#define LOAD_PAIR(ktA) do { _Pragma("unroll") for (int j_ = 0; j_ < TPB; ++j_) { const int kt_ = (ktA) - j_; if (kt_ >= 0) { const int kb_ = kt_ * 64; \
        { const int krow = min(kb_ + r0, LT - 1); kr[j_] = *(const u32x4*)(kg + (size_t)krow * 2048 + cc * 8); } \
        _Pragma("unroll") for (int i = 0; i < NVR; ++i) vr[j_][i] = *(const u32x4*)(vtg + ((size_t)kt_ * 4096 + r0 + 64 * i) * 64 + cc * 8); } } } while (0)
#define STORE_PAIR(stage) do { _Pragma("unroll") for (int j_ = 0; j_ < TPB; ++j_) { bf16_t* Kd = smem + ((stage) * TPB + j_) * BUF; bf16_t* Vd = Kd + KS_ELEMS; \
        *(u32x4*)(Kd + r0 * 72 + cc * 8) = kr[j_]; \
        _Pragma("unroll") for (int i = 0; i < NVR; ++i) *(u32x4*)(Vd + (r0 + 64 * i) * 72 + cc * 8) = vr[j_][i]; } } while (0)
#pragma unroll
    for (int j = 0; j < TPB; ++j) {
        kr[j] = (u32x4){0u, 0u, 0u, 0u};
#pragma unroll
        for (int i = 0; i < NVR; ++i) vr[j][i] = (u32x4){0u, 0u, 0u, 0u};
    }
    LOAD_PAIR(ntiles - 1);
    STORE_PAIR(0);
    __syncthreads();
    bool wskip = false;
    const int npairs = (ntiles + TPB - 1) / TPB;
    for (int pit = 0; pit < npairs; ++pit) {
        const int kt0 = ntiles - 1 - TPB * pit;
        const int cur = pit & 1;
        const bool more = pit + 1 < npairs;
        if (more) LOAD_PAIR(kt0 - TPB);
        float ckl0 = 0.f, ckl1 = 0.f, ckl2 = 0.f;
        if (FOX) { if (kt0 > 0) ckl0 = cum2[kt0 * 64 - 1]; if (kt0 > 1) ckl1 = cum2[(kt0 - 1) * 64 - 1]; if (TPB > 2 && kt0 > 2) ckl2 = cum2[(kt0 - 2) * 64 - 1]; }
#pragma unroll 1
        for (int pj = 0; pj < TPB; ++pj) {
        const int kt = kt0 - pj;
        if (kt < 0) break;
        const bf16_t* Ks = smem + (cur * TPB + pj) * BUF; const bf16_t* Vs = Ks + KS_ELEMS;
        const int kb = kt * 64;
        const float cklast = pj == 0 ? ckl0 : (pj == 1 ? ckl1 : ckl2);
        if (kb < wkend && !wskip) {
        f32x16 s[2];
#pragma unroll
        for (int sub = 0; sub < 2; ++sub) {
            s[sub] = zero16();
#pragma unroll
            for (int ks = 0; ks < 4; ++ks) {
                const bf16x8 a = *(const bf16x8*)(Ks + (sub * 32 + pr) * 72 + ks * 16 + h * 8);
                s[sub] = mfma32(a, qf[ks], s[sub]);
            }
        }
        float mx = -INFINITY;
        if (kb + 63 < qlo) {
#pragma unroll
            for (int sub = 0; sub < 2; ++sub) {
#pragma unroll
                for (int i8 = 0; i8 < 2; ++i8) {
                    const int k0 = kb + sub * 32 + 16 * i8 + 8 * h;
                    float ck[8];
                    float base = 0.f;
                    if (FOX) {
                        const f32x4 c0 = *(const f32x4*)(cum2 + k0), c1v = *(const f32x4*)(cum2 + k0 + 4);
                        ck[0] = c0[0]; ck[1] = c0[1]; ck[2] = c0[2]; ck[3] = c0[3]; ck[4] = c1v[0]; ck[5] = c1v[1]; ck[6] = c1v[2]; ck[7] = c1v[3];
                    } else base = -slope2 * (float)(q - k0);
#pragma unroll
                    for (int e = 0; e < 8; ++e) {
                        const float bias = FOX ? cq - ck[e] : fmaf(slope2, (float)e, base);
                        const float t = fmaf(s[sub][8 * i8 + e], c1, bias);
                        s[sub][8 * i8 + e] = t;
                        mx = fmaxf(mx, t);
                    }
                }
            }
        } else {
#pragma unroll
            for (int sub = 0; sub < 2; ++sub) {
#pragma unroll
                for (int i8 = 0; i8 < 2; ++i8) {
                    const int k0 = kb + sub * 32 + 16 * i8 + 8 * h;
                    float ck[8];
                    if (FOX) {
                        const f32x4 c0 = *(const f32x4*)(cum2 + k0), c1v = *(const f32x4*)(cum2 + k0 + 4);
                        ck[0] = c0[0]; ck[1] = c0[1]; ck[2] = c0[2]; ck[3] = c0[3]; ck[4] = c1v[0]; ck[5] = c1v[1]; ck[6] = c1v[2]; ck[7] = c1v[3];
                    }
#pragma unroll
                    for (int e = 0; e < 8; ++e) {
                        const int k = k0 + e;
                        float t = s[sub][8 * i8 + e] * c1;
                        if (FOX) t += cq - ck[e];
                        else t -= slope2 * fabsf((float)(q - k));
                        t = (k < kend) ? t : -INFINITY;
                        s[sub][8 * i8 + e] = t;
                        mx = fmaxf(mx, t);
                    }
                }
            }
        }
        mx = xmax32(mx);
        const float mn = fmaxf(m, mx);
        if (__any(mn > m)) {
            const float alpha = ex2(m - mn);
            l *= alpha;
#pragma unroll
            for (int dt = 0; dt < NDT; ++dt)
#pragma unroll
                for (int i = 0; i < 16; ++i) O[dt][i] *= alpha;
        }
        m = mn;
#pragma unroll
        for (int sub = 0; sub < 2; ++sub)
#pragma unroll
            for (int i = 0; i < 16; ++i) { const float pv = ex2(s[sub][i] - mn); s[sub][i] = pv; l += pv; }
        bf16x8 pf[2][2];
        pf[0][0] = pack8<0>(s[0]); pf[0][1] = pack8<1>(s[0]); pf[1][0] = pack8<0>(s[1]); pf[1][1] = pack8<1>(s[1]);
#pragma unroll
        for (int dt = 0; dt < NDT; ++dt)
#pragma unroll
            for (int sub = 0; sub < 2; ++sub)
#pragma unroll
                for (int s2 = 0; s2 < 2; ++s2) {
                    const bf16x8 a = *(const bf16x8*)(Vs + (dt * 32 + r) * 72 + sub * 32 + 16 * s2 + 8 * h);
                    O[dt] = mfma32(a, pf[sub][s2], O[dt]);
                }
        }
        if (kt > 0) {
            const int klast = kb - 1;
            float bm = 0.f;
            if (klast < q) bm = FOX ? cq - cklast : -slope2 * (float)(q - klast);
            const bool pred = (q >= LT) || (sbound + bm < m - 152.f);
            wskip = __all(pred);
        }
        }
        if (more) {
            if (lane == 0) flags[cur * 8 + w] = wskip ? 1 : 0;
            STORE_PAIR(cur ^ 1);
        }
        __syncthreads();
        if (more) {
            const int4 f0 = *(const int4*)(flags + cur * 8), f1 = *(const int4*)(flags + cur * 8 + 4);
            if ((f0.x & f0.y & f0.z & f0.w & f1.x & f1.y & f1.z & f1.w) != 0) break;
        }
    }
#undef LOAD_PAIR
#undef STORE_PAIR
    l = xsum32(l);
    const float inv = 1.0f / l;
#pragma unroll
    for (int dt = 0; dt < NDT; ++dt)
#pragma unroll
        for (int i = 0; i < 16; ++i) O[dt][i] *= inv;
}

DI void ph_knorm(const Params& p) {
    const int tid = opaque_tid(), lane = tid & 63;
    const int gw = blockIdx.x * 8 + (tid >> 6), nw = gridDim.x * 8;
    const bf16_t* PQK = (const bf16_t*)(p.ws + OFF_PQK);
    unsigned* knm = (unsigned*)(p.ws + OFF_CNT) + 128;
    for (int u = gw; u < BATCH * 456; u += nw) {
        const int b = u / 456, ch = u - b * 456;
        float mxa = 0.f, mxb = 0.f;
        const bf16_t* base = PQK + ((size_t)b * LT + ch * 18) * 2048 + lane * 8;
#pragma unroll
        for (int i = 0; i < 18; ++i) {
            const u32x4 va = *(const u32x4*)(base + (size_t)i * 2048 + 512), vb = *(const u32x4*)(base + (size_t)i * 2048 + 1536);
            float sa = 0.f, sb = 0.f;
#pragma unroll
            for (int e = 0; e < 4; ++e) {
                const float a0 = __uint_as_float(va[e] << 16), a1 = __uint_as_float(va[e] & 0xffff0000u);
                const float b0 = __uint_as_float(vb[e] << 16), b1 = __uint_as_float(vb[e] & 0xffff0000u);
                sa += a0 * a0 + a1 * a1; sb += b0 * b0 + b1 * b1;
            }
            sa += __shfl_xor(sa, 1); sa += __shfl_xor(sa, 2); sa += __shfl_xor(sa, 4);
            sb += __shfl_xor(sb, 1); sb += __shfl_xor(sb, 2); sb += __shfl_xor(sb, 4);
            mxa = fmaxf(mxa, sa); mxb = fmaxf(mxb, sb);
        }
        if ((lane & 7) == 0) {
            atomicMax(knm + b * 16 + (lane >> 3), __float_as_uint(mxa));
            atomicMax(knm + b * 16 + 8 + (lane >> 3), __float_as_uint(mxb));
        }
    }
}

DI void ph_attn(const Params& p, bf16_t* smem, int* s_item) {
    const int tid = opaque_tid(), lane = tid & 63, w = tid >> 6, r = lane & 31, h = lane >> 5;
    const bf16_t* PQK = (const bf16_t*)(p.ws + OFF_PQK);
    bf16_t* MIX = (bf16_t*)(p.ws + OFF_HB);
    const float lam = ((const float*)(p.ws + OFF_MISC))[0];
    unsigned* ctr = (unsigned*)(p.ws + OFF_CNT);
    const unsigned* knm = (const unsigned*)(p.ws + OFF_CNT) + 128;
    constexpr int NQB = 33, NDIFF = NQB * 16, NITEM = NQB * 48;
    for (;;) {
        __syncthreads();
        if (tid == 0) *s_item = (int)atomicAdd(ctr, 1u);
        __syncthreads();
        const int it = *s_item;
        if (it >= NITEM) break;
        const int cls = it / 132, jj = it - cls * 132;
        const int code = (int)((0xBA7654932108ull >> (4 * (11 - cls))) & 15ull);
        const int qbi = NQB - 1 - (jj >> 2), bi = jj & 3;
        if (code & 8) {
            const int qb = qbi;
            const int q = qb * 256 + w * 32 + r;
            const int b = bi, hd = code & 7;
            const int ntiles = (min(LT, qb * 256 + 272) + 63) >> 6;
            const size_t qrow = (size_t)b * LT + min(q, LT - 1);
            const float slope2 = ex2(-2.f * (float)(hd + 1)) * LOG2E;
            const bf16_t* vt = (const bf16_t*)(p.ws + OFF_VTA) + (size_t)(b * 512 + hd * 128) * 64;
            f32x16 O0[4];
            float* scr = p.out + (size_t)blockIdx.x * 32768 + tid * 64;
            flash<128, false>(O0, PQK + qrow * 2048 + hd * 128, PQK + (size_t)b * LT * 2048 + 512 + hd * 128, vt, ntiles, q, slope2, nullptr, sqrtf(__uint_as_float(knm[b * 16 + hd * 2])), smem);
#pragma unroll
            for (int dt = 0; dt < 4; ++dt)
#pragma unroll
                for (int g = 0; g < 4; ++g) *(f32x4*)(scr + dt * 16 + 4 * g) = (f32x4){O0[dt][4 * g], O0[dt][4 * g + 1], O0[dt][4 * g + 2], O0[dt][4 * g + 3]};
            flash<128, false>(O0, PQK + qrow * 2048 + hd * 128 + 64, PQK + (size_t)b * LT * 2048 + 512 + hd * 128 + 64, vt, ntiles, q, slope2, nullptr, sqrtf(__uint_as_float(knm[b * 16 + hd * 2 + 1])), smem);
            float ss = 0.f;
#pragma unroll
            for (int dt = 0; dt < 4; ++dt)
#pragma unroll
                for (int g = 0; g < 4; ++g) {
                    const f32x4 pv = *(const f32x4*)(scr + dt * 16 + 4 * g);
#pragma unroll
                    for (int e = 0; e < 4; ++e) { const float o = pv[e] - lam * O0[dt][4 * g + e]; O0[dt][4 * g + e] = o; ss += o * o; }
                }
            ss = xsum32(ss);
            const float rn = __frsqrt_rn(ss * (1.0f / 128.0f) + 1e-6f) * 0.8f;
            if (q < LT) {
                bf16_t* d = MIX + qrow * 1024 + hd * 128;
#pragma unroll
                for (int dt = 0; dt < 4; ++dt)
#pragma unroll
                    for (int g = 0; g < 4; ++g) {
                        const int dv = dt * 32 + 8 * g + 4 * h;
                        const f32x4 gg = *(const f32x4*)(p.subln + dv);
                        u32x2 wv; wv[0] = cvt_pk(O0[dt][4 * g] * rn * gg[0], O0[dt][4 * g + 1] * rn * gg[1]);
                        wv[1] = cvt_pk(O0[dt][4 * g + 2] * rn * gg[2], O0[dt][4 * g + 3] * rn * gg[3]);
                        *(u32x2*)(d + dv) = wv;
                    }
            }
        } else {
            const int qb = qbi;
            const int q = qb * 256 + w * 32 + r;
            const int b = bi, hf = code & 7;
            const int ntiles = (min(LT, qb * 256 + 256) + 63) >> 6;
            const size_t qrow = (size_t)b * LT + min(q, LT - 1);
            const bf16_t* vt = (const bf16_t*)(p.ws + OFF_VTA) + (size_t)(2048 + b * 512 + hf * 64) * 64;
            f32x16 O[2];
            flash<64, true>(O, PQK + qrow * 2048 + 1024 + hf * 64, PQK + (size_t)b * LT * 2048 + 1536 + hf * 64, vt, ntiles, q, 0.f,
                            (const float*)(p.ws + OFF_CUMF) + (size_t)(b * 8 + hf) * LP, sqrtf(__uint_as_float(knm[b * 16 + 8 + hf])), smem);
            if (q < LT) {
                bf16_t* d = MIX + qrow * 1024 + 512 + hf * 64;
#pragma unroll
                for (int dt = 0; dt < 2; ++dt)
#pragma unroll
                    for (int g = 0; g < 4; ++g) {
                        const int dv = dt * 32 + 8 * g + 4 * h;
                        u32x2 wv; wv[0] = cvt_pk(O[dt][4 * g], O[dt][4 * g + 1]); wv[1] = cvt_pk(O[dt][4 * g + 2], O[dt][4 * g + 3]);
                        *(u32x2*)(d + dv) = wv;
                    }
            }
        }
    }
}

DI void ph_ln(const Params& p, int lnidx, bool last) {
    const int lane = opaque_tid() & 63;
    const int gw = blockIdx.x * 8 + (opaque_tid() >> 6), nw = gridDim.x * 8;
    float* H = (float*)(p.ws + OFF_H); bf16_t* HB = (bf16_t*)(p.ws + OFF_HB);
    const float* G = p.ln_g + (size_t)lnidx * 1024; const float* Bv = p.ln_b + (size_t)lnidx * 1024;
    f32x4 g[4], bb[4];
#pragma unroll
    for (int i = 0; i < 4; ++i) { g[i] = *(const f32x4*)(G + i * 256 + lane * 4); bb[i] = *(const f32x4*)(Bv + i * 256 + lane * 4); }
    f32x4 nv[4];
    if (gw < MT) {
#pragma unroll
        for (int i = 0; i < 4; ++i) nv[i] = *(const f32x4*)(H + (size_t)gw * 1024 + i * 256 + lane * 4);
    }
    for (int m = gw; m < MT; m += nw) {
        f32x4 v[4];
#pragma unroll
        for (int i = 0; i < 4; ++i) v[i] = nv[i];
        const int mn = min(m + nw, MT - 1);
#pragma unroll
        for (int i = 0; i < 4; ++i) nv[i] = *(const f32x4*)(H + (size_t)mn * 1024 + i * 256 + lane * 4);
        float s = 0.f;
#pragma unroll
        for (int i = 0; i < 4; ++i) s += (v[i][0] + v[i][1]) + (v[i][2] + v[i][3]);
        for (int o = 32; o > 0; o >>= 1) s += __shfl_xor(s, o);
        const float mu = s * (1.0f / 1024.0f);
        float qv = 0.f;
#pragma unroll
        for (int i = 0; i < 4; ++i)
#pragma unroll
            for (int e = 0; e < 4; ++e) { const float d = v[i][e] - mu; qv += d * d; }
        for (int o = 32; o > 0; o >>= 1) qv += __shfl_xor(qv, o);
        const float rstd = __frsqrt_rn(qv * (1.0f / 1024.0f) + 1e-5f);
        const int b = m / LT, pos = m - b * LT;
#pragma unroll
        for (int i = 0; i < 4; ++i) {
            const int c = i * 256 + lane * 4;
            f32x4 y;
#pragma unroll
            for (int e = 0; e < 4; ++e) y[e] = (v[i][e] - mu) * rstd * g[i][e] + bb[i][e];
            if (last) {
                if (pos >= 16) *(f32x4*)(p.out + ((size_t)b * 8192 + (pos - 16)) * 1024 + c) = y;
            } else {
                u32x2 wv; wv[0] = cvt_pk(y[0], y[1]); wv[1] = cvt_pk(y[2], y[3]);
                *(u32x2*)(HB + (size_t)m * 1024 + c) = wv;
            }
        }
        if (!last && lane == 0) ((f32x2*)((unsigned char*)p.out + OFFO_STATS))[m] = (f32x2){mu, rstd};
    }
}

DI void ph_zero_ret_pads(const Params& p) {
    const int tid = opaque_tid();
    for (int idx = blockIdx.x * NT + tid; idx < (128 + 256) * 3 * 64; idx += gridDim.x * NT) {
        const int ch16 = idx & 63, blk = idx >> 6, s_ = blk % 3, g = blk / 3;
        bf16_t* base = g < 128 ? (bf16_t*)(p.ws + OFF_KHATT) + (size_t)(g * 4 + s_) * 512 : (bf16_t*)(p.ws + OFF_VT1) + (size_t)((g - 128) * 4 + s_) * 512;
        *(u32x4*)(base + ch16 * 8) = (u32x4){0u, 0u, 0u, 0u};
    }
}

DI void ph_sprep(const Params& p) {
    const int tid = opaque_tid(), lane = tid & 63, w = tid >> 6, r = lane & 31, h = lane >> 5;
    const int it_ = (w >> 1) & 1, jt = w & 1;
    const bf16_t* QH = (const bf16_t*)((unsigned char*)p.out + OFFO_QHAT);
    const bf16_t* KH = (const bf16_t*)(p.ws + OFF_KHAT);
    bf16_t* SB = (bf16_t*)((unsigned char*)p.out + OFFO_SBUF);
    for (int item = blockIdx.x * 2 + (w >> 2); item < NCH * 16; item += gridDim.x * 2) {
        const int c = item >> 4, b = (item >> 2) & 3, hd = item & 3;
        const int ppi = c * 64 + it_ * 32 + r, ppj = c * 64 + jt * 32 + r;
        const bool vi = ppi >= 48, vj = ppj >= 48;
        const bf16_t* qp = QH + (size_t)item * 16384 + (size_t)it_ * 512 + lane * 8;
        const bf16_t* kp = KH + ((size_t)b * LT + (vj ? ppj - 48 : 0)) * 1024 + hd * 256 + h * 8;
        f32x16 acc = zero16();
        const bf16x8 z8 = {0, 0, 0, 0, 0, 0, 0, 0};
#pragma unroll 8
        for (int s = 0; s < 16; ++s) {
            bf16x8 a = *(const bf16x8*)(qp + ((s >> 1) * 4 + (s & 1) * 2) * 512), bq = *(const bf16x8*)(kp + s * 16);
            if (!vi) a = z8;
            if (!vj) bq = z8;
            acc = mfma32(a, bq, acc);
        }
        const float lg = log2f(1.f - ex2(-5.f - (float)hd));
        const int j = jt * 32 + r;
#pragma unroll
        for (int reg = 0; reg < 16; ++reg) {
            const int i = it_ * 32 + crow(reg, h);
            const int e = (i >= j) ? -64 : 2 * (j - i) - 64;
            SB[sf_off(item, i, j)] = f2bf(acc[reg] * ex2(lg * (float)e));
        }
    }
}

DI void scan_block(const Params& p, const int u) {
    const int tid = opaque_tid(), lane = tid & 63, r = lane & 31, h = lane >> 5;
    const int w = __builtin_amdgcn_readfirstlane(tid >> 6);
    const int sl = u & 15, hd = (u >> 4) & 3, b = u >> 6;
    const float lg = log2f(1.f - ex2(-5.f - (float)hd));
    const float cdec = ex2(lg * 64.f);
    const int it0 = b * 4 + hd;
    constexpr size_t KSTEP = (size_t)16 * 8 * 4 * 512, VSTEP = (size_t)16 * 16 * 4 * 512, SSTEP = (size_t)16 * 8 * 512;
    const bf16_t* KF = (const bf16_t*)(p.ws + OFF_KHATT) + (size_t)(it0 * 8 + w) * 4 * 512 + lane * 8;
    const bf16_t* VG = (const bf16_t*)(p.ws + OFF_VT1) + (size_t)(it0 * 16 + sl) * 4 * 512 + (w & 3) * 512 + lane * 8;
    bf16_t* OB = (bf16_t*)(p.ws + OFF_VT1) + (size_t)(it0 * 16 + sl) * 4 * 512;
    const bf16_t* QF = (const bf16_t*)((unsigned char*)p.out + OFFO_QHAT) + (size_t)(it0 * 8 + w) * 4 * 512 + lane * 8;
    const bf16_t* SF = (const bf16_t*)((unsigned char*)p.out + OFFO_SBUF) + (size_t)it0 * 8 * 512 + ((w >> 2) * 4 + (w & 3)) * 512 + lane * 8;
    float* PART = (float*)((unsigned char*)p.out + OFFO_PART);
    f32x4* red = (f32x4*)dsm;
    bf16_t* vlds = (bf16_t*)(dsm + SMEM_BYTES + 4096);
    const bf16x8 z8 = {0, 0, 0, 0, 0, 0, 0, 0};
    const bool ok0 = r >= 48 - 0, ok1 = false;
    (void)ok0; (void)ok1;

    f32x16 st = zero16();
    bf16x8 kaA[4], qA[2][2], sA, kaB[4], qB[2][2], sB, kaC[4], qC[2][2], sC;
    bf16x8 vg = z8, vg2 = z8;
#define LOADSET(KA_, Q_, S_, c_) do { const int cc_ = min((c_), NCH - 1); \
        _Pragma("unroll") for (int s_ = 0; s_ < 4; ++s_) KA_[s_] = *(const bf16x8*)(KF + cc_ * KSTEP + s_ * 512); \
        _Pragma("unroll") for (int it_ = 0; it_ < 2; ++it_) { \
            Q_[it_][0] = *(const bf16x8*)(QF + cc_ * KSTEP + (0 * 2 + it_) * 512); Q_[it_][1] = *(const bf16x8*)(QF + cc_ * KSTEP + (1 * 2 + it_) * 512); \
            if (cc_ * 64 + it_ * 32 + r < 48) { Q_[it_][0] = z8; Q_[it_][1] = z8; } } \
        S_ = *(const bf16x8*)(SF + cc_ * SSTEP); } while (0)
#define SCAN_STEP(c_, KA_, Q_, S_, KL_, QL_, SL_) do { const int c = (c_); \
        if (w < 4) { *(bf16x8*)(vlds + (((c + 1) & 1) * 4 + w) * 512 + lane * 8) = vg; vg = vg2; vg2 = *(const bf16x8*)(VG + (size_t)min(c + 3, NCH - 1) * VSTEP); } \
        LOADSET(KL_, QL_, SL_, c + 2); \
        bf16x8 vf[4]; \
        _Pragma("unroll") for (int s_ = 0; s_ < 4; ++s_) vf[s_] = *(const bf16x8*)(vlds + ((c & 1) * 4 + s_) * 512 + lane * 8); \
        const bf16x8 vw = *(const bf16x8*)(vlds + ((c & 1) * 4 + (w & 3)) * 512 + lane * 8); \
        f32x16 o0 = zero16(), o1 = zero16(); \
        if (w < 4) o0 = mfma32(vw, S_, o0); else o1 = mfma32(vw, S_, o1); \
        { const bf16x8 a0 = pack8<0>(st), a1 = pack8<1>(st); \
          o0 = mfma32(a0, Q_[0][0], o0); o1 = mfma32(a0, Q_[1][0], o1); o0 = mfma32(a1, Q_[0][1], o0); o1 = mfma32(a1, Q_[1][1], o1); } \
        _Pragma("unroll") for (int i = 0; i < 16; ++i) st[i] *= cdec; \
        _Pragma("unroll") for (int s_ = 0; s_ < 4; ++s_) st = mfma32(KA_[s_], vf[s_], st); \
        f32x4* rb = red + (size_t)(((c & 1) * 8 + w) * 8) * 64 + lane; \
        _Pragma("unroll") for (int g = 0; g < 4; ++g) { \
            rb[(0 * 4 + g) * 64] = (f32x4){o0[4 * g], o0[4 * g + 1], o0[4 * g + 2], o0[4 * g + 3]}; \
            rb[(1 * 4 + g) * 64] = (f32x4){o1[4 * g], o1[4 * g + 1], o1[4 * g + 2], o1[4 * g + 3]}; } \
        __syncthreads(); \
        { const int it2 = w >> 2, g2 = w & 3; \
          const f32x4* rr = red + (size_t)((c & 1) * 8 * 8 + it2 * 4 + g2) * 64 + lane; \
          f32x4 a = rr[0]; \
          _Pragma("unroll") for (int wv = 1; wv < 8; ++wv) { const f32x4 t = rr[(size_t)wv * 8 * 64]; a[0] += t[0]; a[1] += t[1]; a[2] += t[2]; a[3] += t[3]; } \
          const int pp = c * 64 + it2 * 32 + r; \
          float ss = (a[0] * a[0] + a[1] * a[1]) + (a[2] * a[2] + a[3] * a[3]); \
          ss = xsum32(ss); \
          const int i_ = it2 * 32 + r; \
          bf16_t* od = OB + c * VSTEP + (size_t)((i_ >> 4) * 64 + ((i_ >> 3) & 1) * 32 + 8 * g2 + 4 * h) * 8 + (i_ & 7); \
          od[0] = f2bf(a[0]); od[8] = f2bf(a[1]); od[16] = f2bf(a[2]); od[24] = f2bf(a[3]); \
          if (h == 0 && pp >= 48) PART[((size_t)b * LT + pp - 48) * 256 + hd * 64 + sl * 4 + g2] = ss; } } while (0)

    if (w < 4) { const bf16x8 v0 = *(const bf16x8*)(VG); *(bf16x8*)(vlds + w * 512 + lane * 8) = v0; vg = *(const bf16x8*)(VG + VSTEP); vg2 = *(const bf16x8*)(VG + 2 * VSTEP); }
    LOADSET(kaA, qA, sA, 0);
    LOADSET(kaB, qB, sB, 1);
    __syncthreads();
    for (int c3 = 0; c3 < NCH; c3 += 3) {
        SCAN_STEP(c3, kaA, qA, sA, kaC, qC, sC);
        SCAN_STEP(c3 + 1, kaB, qB, sB, kaA, qA, sA);
        SCAN_STEP(c3 + 2, kaC, qC, sC, kaB, qB, sB);
    }
#undef LOADSET
#undef SCAN_STEP
    __syncthreads();
}

DI void ph_scan(const Params& p) {
    for (int ub = blockIdx.x; ub < 256; ub += gridDim.x) {
        const int xcd = ub & 7, j = ub >> 3;
        scan_block(p, ((xcd * 2 + (j >> 4)) << 4) | (j & 15));
    }
}

constexpr int NPHASE = 18;
template <int ph>
DI void run_phase(const Params& p, bf16_t* smem, float* s_aux) {
    const bf16_t* HB = (const bf16_t*)(p.ws + OFF_HB);
    switch (ph) {
        case 0: ph_prologue(p, smem); ph_fb(p); break;
        case 1: ph_gemm<EPI_E1, 1024>(p, HB, (const bf16_t*)(p.ws + OFF_W0IN), 3072, s_aux); break;
        case 2: ph_cumsum(p, smem); ph_knorm(p); break;
        case 3: ph_attn(p, smem, (int*)(s_aux + 256)); break;
        case 4: ph_gemm<EPI_RESID, 1024>(p, HB, (const bf16_t*)(p.ws + OFF_W0OUT), 1024, s_aux); break;
        case 5: ph_ln(p, 0, false); break;
        case 6: ph_gemm<EPI_FFN1, 1024>(p, HB, (const bf16_t*)(p.ws + OFF_F1), 4096, s_aux); break;
        case 7: ph_gemm<EPI_RESID, 4096, 0>(p, (const bf16_t*)(p.ws + OFF_U), (const bf16_t*)(p.ws + OFF_F2), 1024, s_aux); break;
        case 8: ph_ln(p, 1, false); break;
        case 9: ph_zero_ret_pads(p); ph_gemm<EPI_E5, 1024>(p, HB, (const bf16_t*)(p.ws + OFF_W1IN), 4096, s_aux); break;
        case 10: ph_sprep(p); break;
        case 11: ph_scan(p); break;
        case 12: ph_gemm<EPI_E5B, 1024>(p, HB, (const bf16_t*)(p.ws + OFF_W1IN) + (size_t)4096 * 1024, 2048, s_aux); break;
        case 13: ph_gemm<EPI_RESID, 2048, 1>(p, (const bf16_t*)(p.ws + OFF_YB), (const bf16_t*)(p.ws + OFF_W1OUT), 1024, s_aux); break;
        case 14: ph_ln(p, 2, false); break;
        case 15: ph_gemm<EPI_FFN1, 1024>(p, HB, (const bf16_t*)(p.ws + OFF_F1 + SZ_F), 4096, s_aux); break;
        case 16: ph_gemm<EPI_RESID, 4096, 2>(p, (const bf16_t*)(p.ws + OFF_U), (const bf16_t*)(p.ws + OFF_F2 + SZ_F), 1024, s_aux); break;
        case 17: ph_ln(p, 3, true); break;
    }
}

__global__ void __launch_bounds__(512, 2) k_mega(Params p) {
    bf16_t* smem = (bf16_t*)dsm;
    float* s_aux = (float*)(dsm + SMEM_BYTES);
    uint4* xbw = (uint4*)(dsm + SMEM_BYTES + 1536);
    cg::grid_group grid = cg::this_grid();
    if (opaque_tid() == 0) *xbw = make_uint4(0u, 0u, 0u, 0u);
    __syncthreads();
    const XcdBarrier xb = xcd_barrier_post((unsigned*)(p.ws + OFF_BAR), (volatile LAS unsigned*)xbw);
    if (p.ws == nullptr) grid.sync();
#define PHS(N) run_phase<N>(p, smem, s_aux); xcd_barrier(xb);
    PHS(0) PHS(1) PHS(2) PHS(3) PHS(4) PHS(5) PHS(6) PHS(7) PHS(8) PHS(9) PHS(10) PHS(11) PHS(12) PHS(13) PHS(14) PHS(15) PHS(16)
    run_phase<17>(p, smem, s_aux);
}

extern "C" void kernel_launch(void* const* d_in, const int* in_sizes, int n_in, void* d_out, int out_size, void* d_ws, size_t ws_size, hipStream_t stream) {
    Params p{};
    p.x = (const float*)d_in[0]; p.meta = (const float*)d_in[1]; p.ew_in = (const float*)d_in[2]; p.ef_bias = (const float*)d_in[3];
    p.dlam = (const float*)d_in[4]; p.subln = (const float*)d_in[5]; p.ew_out = (const float*)d_in[6]; p.rw_in = (const float*)d_in[7];
    p.rw_out = (const float*)d_in[8]; p.ln_g = (const float*)d_in[9]; p.ln_b = (const float*)d_in[10]; p.f_w1 = (const float*)d_in[11];
    p.f_w2 = (const float*)d_in[12]; p.out = (float*)d_out; p.ws = (unsigned char*)d_ws;
    if (ws_size < WS_END) { fprintf(stderr, "workspace too small: %zu < %zu\n", ws_size, (size_t)WS_END); }
    static int grid_blocks = 0;
    if (!grid_blocks) {
        int dev = 0, cus = 0, per_cu = 0;
        hipGetDevice(&dev);
        hipDeviceGetAttribute(&cus, hipDeviceAttributeMultiprocessorCount, dev);
        (void)hipFuncSetAttribute((const void*)k_mega, hipFuncAttributeMaxDynamicSharedMemorySize, DSM_BYTES);
        (void)hipOccupancyMaxActiveBlocksPerMultiprocessor(&per_cu, k_mega, NT, DSM_BYTES);
        if (per_cu < 1) fprintf(stderr, "occupancy query returned %d\n", per_cu);
        grid_blocks = cus;
    }
    void* args[] = {&p};
    (void)hipMemsetAsync((unsigned char*)d_ws + OFF_BAR, 0, 16384 + 4096, stream);
    hipError_t e = hipLaunchCooperativeKernel((void*)k_mega, dim3(grid_blocks), dim3(NT), args, DSM_BYTES, stream);
    if (e != hipSuccess) fprintf(stderr, "cooperative launch failed: %s (grid %d)\n", hipGetErrorString(e), grid_blocks);
}
```
